# Optimizing an MI355X kernel written in HIP

```python
import jax
import jax.numpy as jnp
from jax import lax
import numpy as np

D_MODEL = 1024
BATCH = 8
SEQ = 2048
DEPTH = 2

GRID_W = 64
CTX_LEN = 256
N_EVEN = (DEPTH + 1) // 2
N_ODD = DEPTH // 2

A_WIDTH = 512
A_HEADS = 8
A_HEAD_DIM = A_WIDTH // A_HEADS
A_CONV_W = 4
LRU_C = 8.0
B_WIDTH = 512
B_CONV_W = 31
AB_IN = 2 * A_WIDTH + 2 * B_WIDTH
AB_OUT = A_WIDTH + B_WIDTH

C_WIDTH = 512
C_HEADS = 8
C_HEAD_DIM = C_WIDTH // C_HEADS
CHUNK = 128
D_WIDTH = 512
D_GROUPS = 4
D_GROUP_DIM = D_WIDTH // D_GROUPS
CD_IN = 2 * C_WIDTH + D_WIDTH
CD_OUT = C_WIDTH + D_WIDTH

D_FF = 2816
N_EXPERTS = 8
TOP_K = 2
D_FF_EXPERT = 3584

NORM_EPS = 1e-6
LN_EPS = 1e-5
POS_THETA = 10000.0

kernel_name = "hybrid_rglru_conformer_gmlp_fnet_moe_prefix_dit"


def rmsnorm(x, g):
    xf = x.astype(jnp.float32)
    xf = xf * lax.rsqrt(jnp.mean(xf * xf, axis=-1, keepdims=True) + NORM_EPS)
    return (xf * g.astype(jnp.float32)).astype(x.dtype)


def layernorm(x, g, b):
    xf = x.astype(jnp.float32)
    mu = jnp.mean(xf, axis=-1, keepdims=True)
    var = jnp.mean(jnp.square(xf - mu), axis=-1, keepdims=True)
    y = (xf - mu) * lax.rsqrt(var + LN_EPS) * g.astype(jnp.float32) + b.astype(jnp.float32)
    return y.astype(x.dtype)


def dwconv(x, w, b):
    y = lax.conv_general_dilated(x, w[:, None, :], window_strides=(1,), padding='SAME',
                                 dimension_numbers=('NWC', 'WIO', 'NWC'),
                                 feature_group_count=x.shape[-1])
    return y + b


def grid_pos_embed(rows):
    row = jnp.repeat(jnp.arange(rows, dtype=jnp.float32), GRID_W)
    col = jnp.tile(jnp.arange(GRID_W, dtype=jnp.float32), rows)
    n_freq = D_MODEL // 4
    omega = POS_THETA ** (-jnp.arange(n_freq, dtype=jnp.float32) / n_freq)
    ang_r = row[:, None] * omega
    ang_c = col[:, None] * omega
    return jnp.concatenate([jnp.sin(ang_r), jnp.cos(ang_r), jnp.sin(ang_c), jnp.cos(ang_c)], axis=-1)


def ada_terms(cvec, w_ada, b_ada):
    m = jax.nn.silu(cvec) @ w_ada + b_ada
    if m.ndim == 2:
        m = m[:, None, :]
    return jnp.split(m, 6, axis=-1)


def lru_coeffs(x, w_r, b_r, w_i, b_i, lam):
    bsz, length, _ = x.shape
    xh = x.reshape(bsz, length, A_HEADS, A_HEAD_DIM)
    r = jax.nn.sigmoid(jnp.einsum('blhd,hde->blhe', xh, w_r).reshape(bsz, length, A_WIDTH).astype(jnp.float32)
                       + b_r.astype(jnp.float32))
    i = jax.nn.sigmoid(jnp.einsum('blhd,hde->blhe', xh, w_i).reshape(bsz, length, A_WIDTH).astype(jnp.float32)
                       + b_i.astype(jnp.float32))
    log_a = -LRU_C * r * jax.nn.softplus(-lam.astype(jnp.float32))
    b = jnp.sqrt(-jnp.expm1(2.0 * log_a)) * (i * x.astype(jnp.float32))
    return jnp.exp(log_a), b


def linear_scan(a, b, h0):
    def combine(left, right):
        return left[0] * right[0], right[0] * left[1] + right[1]
    a_cum, b_cum = lax.associative_scan(combine, (a, b), axis=1)
    return a_cum * h0[:, None, :] + b_cum


def rglru_direction(x_ctx, x_lat, w_r, b_r, w_i, b_i, lam, reverse):
    a_c, b_c = lru_coeffs(x_ctx, w_r, b_r, w_i, b_i, lam)
    a_l, b_l = lru_coeffs(x_lat, w_r, b_r, w_i, b_i, lam)
    if reverse:
        a_c, b_c, a_l, b_l = (jnp.flip(t, axis=1) for t in (a_c, b_c, a_l, b_l))
    h_c = linear_scan(a_c, b_c, jnp.zeros_like(b_c[:, 0]))
    h_l = linear_scan(a_l, b_l, h_c[:, -1])
    if reverse:
        h_c, h_l = jnp.flip(h_c, axis=1), jnp.flip(h_l, axis=1)
    return h_c, h_l


def mixer_ab(h_lat, h_ctx, w_in, conv_w, conv_b, w_r, b_r, w_i, b_i, lam, dw_w, dw_b, ln_g, ln_b, w_out):
    def branches(h):
        z = h @ w_in
        xa, ga, vb, gb = jnp.split(z, [A_WIDTH, 2 * A_WIDTH, 2 * A_WIDTH + B_WIDTH], axis=-1)
        xa = dwconv(xa, conv_w, conv_b)
        u = dwconv(vb * jax.nn.sigmoid(gb), dw_w, dw_b)
        u = jax.nn.silu(layernorm(u, ln_g, ln_b))
        return xa, jax.nn.gelu(ga), u
    xa_c, ga_c, u_c = branches(h_ctx)
    xa_l, ga_l, u_l = branches(h_lat)
    fwd_c, fwd_l = rglru_direction(xa_c, xa_l, w_r[0], b_r[0], w_i[0], b_i[0], lam[0], reverse=False)
    bwd_c, bwd_l = rglru_direction(xa_c, xa_l, w_r[1], b_r[1], w_i[1], b_i[1], lam[1], reverse=True)
    rec_c = (fwd_c + bwd_c).astype(ga_c.dtype) * ga_c
    rec_l = (fwd_l + bwd_l).astype(ga_l.dtype) * ga_l
    y_c = jnp.concatenate([rec_c, u_c], axis=-1) @ w_out
    y_l = jnp.concatenate([rec_l, u_l], axis=-1) @ w_out
    return y_l, y_c


def spatial_gating(u, v, ln_g, ln_b, w_s, b_s):
    bsz, length, _ = v.shape
    v = layernorm(v, ln_g, ln_b)
    vh = v.reshape(bsz, length // CHUNK, CHUNK, C_HEADS, C_HEAD_DIM)
    mixed = jnp.einsum('hpq,bnqhd->bnphd', w_s, vh) + b_s.T[:, :, None]
    return u * mixed.reshape(bsz, length, C_WIDTH)


def fourier_mix(z):
    bsz, length, _ = z.shape
    zg = z.astype(jnp.float32).reshape(bsz, length, D_GROUPS, D_GROUP_DIM).transpose(0, 2, 1, 3)
    f = jnp.fft.fft2(zg, norm='ortho').real
    return f.transpose(0, 2, 1, 3).reshape(bsz, length, D_WIDTH).astype(z.dtype)


def mixer_cd(h, w_in, ln_g, ln_b, w_s, b_s, w_out):
    z = h @ w_in
    uv, f = z[..., :2 * C_WIDTH], z[..., 2 * C_WIDTH:]
    u, v = jnp.split(jax.nn.gelu(uv), 2, axis=-1)
    return jnp.concatenate([spatial_gating(u, v, ln_g, ln_b, w_s, b_s), fourier_mix(f)], axis=-1) @ w_out


def swiglu(x, w1, w3, w2):
    return (jax.nn.silu(x @ w1) * (x @ w3)) @ w2


def moe_swiglu(x, router, w1, w3, w2):
    logits = (x @ router).astype(jnp.float32)
    top_v, top_i = lax.top_k(logits, TOP_K)
    probs = jax.nn.softmax(top_v, axis=-1)
    gates = jnp.sum(jax.nn.one_hot(top_i, N_EXPERTS, dtype=jnp.float32) * probs[..., None], axis=-2)
    gates = gates.astype(x.dtype)
    out = jnp.zeros_like(x)
    for e in range(N_EXPERTS):
        out = out + gates[..., e:e + 1] * swiglu(x, w1[e], w3[e], w2[e])
    return out


def setup_inputs(seed: int = 0) -> dict:
    key = jax.random.key(seed)
    ks = iter(jax.random.split(key, 48))
    D = D_MODEL

    def nrm(shape, scale):
        return scale * jax.random.normal(next(ks), shape, jnp.float32)

    u = jax.random.uniform(next(ks), (N_EVEN, 2, A_WIDTH), jnp.float32, 0.9, 0.999)
    a0 = u ** (1.0 / LRU_C)
    rg_lambda = jnp.log(a0) - jnp.log1p(-a0)
    return {
        'x': nrm((BATCH, SEQ, D), 1.0),
        'c': nrm((BATCH, D), 1.0),
        'ctx': nrm((BATCH, CTX_LEN, D), 1.0),
        'c_ctx': nrm((D,), 1.0),
        'ada_w': nrm((DEPTH, D, 6 * D), 0.5 * D ** -0.5),
        'ada_b': nrm((DEPTH, 6 * D), 0.02),
        'norm_g': 1.0 + nrm((DEPTH, 4, D), 0.1),
        'ab_w_in': nrm((N_EVEN, D, AB_IN), D ** -0.5),
        'rg_conv_w': nrm((N_EVEN, A_CONV_W, A_WIDTH), A_CONV_W ** -0.5),
        'rg_conv_b': nrm((N_EVEN, A_WIDTH), 0.02),
        'rg_w_r': nrm((N_EVEN, 2, A_HEADS, A_HEAD_DIM, A_HEAD_DIM), A_HEAD_DIM ** -0.5),
        'rg_b_r': nrm((N_EVEN, 2, A_WIDTH), 0.02),
        'rg_w_i': nrm((N_EVEN, 2, A_HEADS, A_HEAD_DIM, A_HEAD_DIM), A_HEAD_DIM ** -0.5),
        'rg_b_i': nrm((N_EVEN, 2, A_WIDTH), 0.02),
        'rg_lambda': rg_lambda,
        'cv_dw_w': nrm((N_EVEN, B_CONV_W, B_WIDTH), B_CONV_W ** -0.5),
        'cv_dw_b': nrm((N_EVEN, B_WIDTH), 0.02),
        'cv_ln_g': 1.0 + nrm((N_EVEN, B_WIDTH), 0.1),
        'cv_ln_b': nrm((N_EVEN, B_WIDTH), 0.02),
        'ab_w_out': nrm((N_EVEN, AB_OUT, D), AB_OUT ** -0.5),
        'ffn_w1': nrm((N_EVEN, D, D_FF), D ** -0.5),
        'ffn_w3': nrm((N_EVEN, D, D_FF), D ** -0.5),
        'ffn_w2': nrm((N_EVEN, D_FF, D), D_FF ** -0.5),
        'cd_w_in': nrm((N_ODD, D, CD_IN), D ** -0.5),
        'sg_ln_g': 1.0 + nrm((N_ODD, C_WIDTH), 0.1),
        'sg_ln_b': nrm((N_ODD, C_WIDTH), 0.02),
        'sg_w_s': nrm((N_ODD, C_HEADS, CHUNK, CHUNK), CHUNK ** -0.5),
        'sg_b_s': 1.0 + nrm((N_ODD, C_HEADS, CHUNK), 0.1),
        'cd_w_out': nrm((N_ODD, CD_OUT, D), CD_OUT ** -0.5),
        'moe_router': nrm((N_ODD, D, N_EXPERTS), D ** -0.5),
        'moe_w1': nrm((N_ODD, N_EXPERTS, D, D_FF_EXPERT), D ** -0.5),
        'moe_w3': nrm((N_ODD, N_EXPERTS, D, D_FF_EXPERT), D ** -0.5),
        'moe_w2': nrm((N_ODD, N_EXPERTS, D_FF_EXPERT, D), D_FF_EXPERT ** -0.5),
    }


def reference(x, c, ctx, c_ctx, ada_w, ada_b, norm_g,
              ab_w_in, rg_conv_w, rg_conv_b, rg_w_r, rg_b_r, rg_w_i, rg_b_i, rg_lambda,
              cv_dw_w, cv_dw_b, cv_ln_g, cv_ln_b, ab_w_out,
              ffn_w1, ffn_w3, ffn_w2,
              cd_w_in, sg_ln_g, sg_ln_b, sg_w_s, sg_b_s, cd_w_out,
              moe_router, moe_w1, moe_w3, moe_w2):
    ROWS = x.shape[1] // GRID_W
    x = x + grid_pos_embed(ROWS).astype(x.dtype)
    xc = ctx
    for layer in range(DEPTH):
        j = layer // 2
        keep_ctx = layer < DEPTH - 1
        sh1, sc1, g1, sh2, sc2, g2 = ada_terms(c, ada_w[layer], ada_b[layer])
        sh1c, sc1c, g1c, sh2c, sc2c, g2c = ada_terms(c_ctx, ada_w[layer], ada_b[layer])
        g_pre_mix, g_post_mix, g_pre_ffn, g_post_ffn = norm_g[layer]

        h = rmsnorm(x, g_pre_mix) * (1.0 + sc1) + sh1
        hc = rmsnorm(xc, g_pre_mix) * (1.0 + sc1c) + sh1c
        if layer % 2 == 0:
            y, yc = mixer_ab(h, hc, ab_w_in[j], rg_conv_w[j], rg_conv_b[j], rg_w_r[j], rg_b_r[j],
                             rg_w_i[j], rg_b_i[j], rg_lambda[j], cv_dw_w[j], cv_dw_b[j],
                             cv_ln_g[j], cv_ln_b[j], ab_w_out[j])
        else:
            y = mixer_cd(h, cd_w_in[j], sg_ln_g[j], sg_ln_b[j], sg_w_s[j], sg_b_s[j], cd_w_out[j])
            if keep_ctx:
                yc = mixer_cd(hc, cd_w_in[j], sg_ln_g[j], sg_ln_b[j], sg_w_s[j], sg_b_s[j], cd_w_out[j])
        x = x + g1 * rmsnorm(y, g_post_mix)
        if keep_ctx:
            xc = xc + g1c * rmsnorm(yc, g_post_mix)

        if layer % 2 == 0:
            ffn = lambda t: swiglu(t, ffn_w1[j], ffn_w3[j], ffn_w2[j])
        else:
            ffn = lambda t: moe_swiglu(t, moe_router[j], moe_w1[j], moe_w3[j], moe_w2[j])
        x = x + g2 * rmsnorm(ffn(rmsnorm(x, g_pre_ffn) * (1.0 + sc2) + sh2), g_post_ffn)
        if keep_ctx:
            xc = xc + g2c * rmsnorm(ffn(rmsnorm(xc, g_pre_ffn) * (1.0 + sc2c) + sh2c), g_post_ffn)
    return x
```

```cpp
#include <hip/hip_runtime.h>
#include <cstdint>
#include <cstdio>

typedef unsigned short bf16;
#define DEV __device__ __forceinline__

constexpr int NB = 8, SEQ = 2048, DM = 1024, CTXL = 256, GRIDW = 64;
constexpr int NTOK = NB * SEQ;
constexpr int NCTX = NB * CTXL;
constexpr int NROWS = NTOK + NCTX;
constexpr int AW = 512, AHEADS = 8, AHD = 64, BWD = 512, CONVB = 31;
constexpr int CWD = 512, CHEADS = 8, CHD = 64, CHUNK = 128, DWD = 512, DGROUPS = 4, DGD = 128;
constexpr int DFF = 2816, NE = 8, DFE = 3584;
constexpr float NORM_EPS = 1e-6f, LN_EPS = 1e-5f;

DEV float bf2f(bf16 h) { return __uint_as_float((unsigned)h << 16); }
DEV bf16 f2bf(float f) { unsigned u = __float_as_uint(f); return (bf16)((u + 0x7fffu + ((u >> 16) & 1u)) >> 16); }
DEV float sigmoid_f(float x) { return 1.f / (1.f + expf(-x)); }
DEV float silu_f(float x) { return x * sigmoid_f(x); }
DEV float gelu_tanh_f(float x) { const float u = 0.7978845608028654f * (x + 0.044715f * x * x * x); return 0.5f * x * (1.f + tanhf(u)); }
DEV float softplus_f(float x) { return x > 20.f ? x : log1pf(expf(x)); }
DEV float wave_sum(float v) {
#pragma unroll
    for (int o = 32; o > 0; o >>= 1) v += __shfl_xor(v, o);
    return v;
}
template <int NW> DEV float block_sum(float v, float* sm) {
    v = wave_sum(v);
    __syncthreads();
    if ((threadIdx.x & 63) == 0) sm[threadIdx.x >> 6] = v;
    __syncthreads();
    float t = 0.f;
#pragma unroll
    for (int i = 0; i < NW; ++i) t += sm[i];
    return t;
}

__global__ void k_ada(const float* __restrict__ c, const float* __restrict__ cctx, const float* __restrict__ ada_w, const float* __restrict__ ada_b, float* __restrict__ ADA) {
    const int idx = blockIdx.x * blockDim.x + threadIdx.x;
    if (idx >= 2 * 9 * 6 * DM) return;
    const int j = idx % (6 * DM), r = (idx / (6 * DM)) % 9, l = idx / (6 * DM * 9);
    const float* src = r < 8 ? c + r * DM : cctx;
    const float* w = ada_w + (size_t)l * DM * 6 * DM + j;
    float acc = ada_b[l * 6 * DM + j];
    for (int k = 0; k < DM; ++k) acc += silu_f(src[k]) * w[(size_t)k * 6 * DM];
    ADA[idx] = acc;
}

__global__ void k_posadd(const float* __restrict__ x, float* __restrict__ X) {
    const size_t idx = (size_t)blockIdx.x * blockDim.x + threadIdx.x;
    if (idx >= (size_t)NTOK * DM) return;
    const int d = (int)(idx % DM), t = (int)((idx / DM) % SEQ);
    const int q = d / 256, f = d % 256;
    const float omega = powf(10000.f, -(float)f / 256.f);
    const float pos = (q < 2) ? (float)(t / GRIDW) : (float)(t % GRIDW);
    const float ang = pos * omega;
    const float pe = (q & 1) ? cosf(ang) : sinf(ang);
    X[idx] = x[idx] + pe;
}

__global__ void __launch_bounds__(256) k_norm_mod(const float* __restrict__ Xin, bf16* __restrict__ H, int rows_per_batch, const float* __restrict__ gain,
                                                   const float* __restrict__ ADAl, int sh_off, int sc_off, int fixed_row) {
    __shared__ float sm[4];
    const int row = blockIdx.x, tid = threadIdx.x;
    const int arow = fixed_row >= 0 ? fixed_row : row / rows_per_batch;
    const float4 v = *(const float4*)(Xin + (size_t)row * DM + tid * 4);
    const float ss = block_sum<4>(v.x * v.x + v.y * v.y + v.z * v.z + v.w * v.w, sm);
    const float r = rsqrtf(ss * (1.f / DM) + NORM_EPS);
    const float* a = ADAl + (size_t)arow * 6 * DM;
    const float xs[4] = {v.x, v.y, v.z, v.w};
#pragma unroll
    for (int i = 0; i < 4; ++i) {
        const int d = tid * 4 + i;
        const float h = (xs[i] * r * gain[d]) * (1.f + a[sc_off + d]) + a[sh_off + d];
        H[(size_t)row * DM + d] = f2bf(h);
    }
}

__global__ void k_wt(const float* __restrict__ W, int ldw, int col0, int ncols, int K, bf16* __restrict__ Wt, int row_off, int mode, int half) {
    const size_t idx = (size_t)blockIdx.x * blockDim.x + threadIdx.x;
    if (idx >= (size_t)ncols * K) return;
    const int n = (int)(idx % ncols), k = (int)(idx / ncols);
    const int nm = mode ? (n / 128) * 256 + half * 128 + (n % 128) : n;
    Wt[(size_t)(row_off + nm) * K + k] = f2bf(W[(size_t)k * ldw + col0 + n]);
}

DEV void unpack8(const uint4 v, float* f) {
    f[0] = __uint_as_float(v.x << 16); f[1] = __uint_as_float(v.x & 0xffff0000u);
    f[2] = __uint_as_float(v.y << 16); f[3] = __uint_as_float(v.y & 0xffff0000u);
    f[4] = __uint_as_float(v.z << 16); f[5] = __uint_as_float(v.z & 0xffff0000u);
    f[6] = __uint_as_float(v.w << 16); f[7] = __uint_as_float(v.w & 0xffff0000u);
}
template <bool PAIRED, class Epi>
__global__ void __launch_bounds__(256) k_gemm(const bf16* __restrict__ A, const bf16* __restrict__ Bt, int K, const float* __restrict__ rowgate, Epi epi) {
    const int lane = threadIdx.x & 63, rg = threadIdx.x >> 6;
    const int L = blockIdx.x * 64 + lane;
    const int r0 = blockIdx.y * 32 + rg * 8;
    const int n0 = PAIRED ? (L / 128) * 256 + (L % 128) : L;
    const bf16* b0 = Bt + (size_t)n0 * K;
    const bf16* b1 = b0 + (size_t)128 * K;
    float acc0[8], acc1[8];
    bool act[8];
    bool any = false;
#pragma unroll
    for (int i = 0; i < 8; ++i) { acc0[i] = 0.f; acc1[i] = 0.f; act[i] = rowgate ? (rowgate[r0 + i] != 0.f) : true; any |= act[i]; }
    if (!any) return;
    for (int k = 0; k < K; k += 8) {
        float fb0[8], fb1[8];
        unpack8(*(const uint4*)(b0 + k), fb0);
        if (PAIRED) unpack8(*(const uint4*)(b1 + k), fb1);
#pragma unroll
        for (int i = 0; i < 8; ++i) {
            if (act[i]) {
                float fa[8];
                unpack8(*(const uint4*)(A + (size_t)(r0 + i) * K + k), fa);
#pragma unroll
                for (int j = 0; j < 8; ++j) { acc0[i] += fa[j] * fb0[j]; if (PAIRED) acc1[i] += fa[j] * fb1[j]; }
            }
        }
    }
#pragma unroll
    for (int i = 0; i < 8; ++i) if (act[i]) epi(r0 + i, L, acc0[i], acc1[i]);
}

struct EpIn0 {
    bf16* XA_RAW; bf16* GA;
    DEV void operator()(int row, int col, float v, float) const {
        if (col < AW) XA_RAW[(size_t)row * AW + col] = f2bf(v);
        else if (row < NTOK) GA[(size_t)row * AW + (col - AW)] = f2bf(gelu_tanh_f(v));
    }
};
struct EpGlu { bf16* O; int ldc; int pad; DEV void operator()(int row, int col, float v0, float v1) const { O[(size_t)row * ldc + col] = f2bf(v0 * sigmoid_f(v1)); } };
struct EpSwiglu { bf16* O; int ldc; int pad; DEV void operator()(int row, int col, float v0, float v1) const { O[(size_t)row * ldc + col] = f2bf(silu_f(v0) * v1); } };
struct EpPlainBf16 { bf16* O; int ldc; int pad; DEV void operator()(int row, int col, float v, float) const { O[(size_t)row * ldc + col] = f2bf(v); } };
struct EpIn1 {
    bf16* U; bf16* V; bf16* F;
    DEV void operator()(int row, int col, float v, float) const {
        if (col < CWD) U[(size_t)row * CWD + col] = f2bf(gelu_tanh_f(v));
        else if (col < 2 * CWD) V[(size_t)row * CWD + (col - CWD)] = f2bf(gelu_tanh_f(v));
        else F[(size_t)row * DWD + (col - 2 * CWD)] = f2bf(v);
    }
};
struct EpDft {
    bf16* A3;
    DEV void operator()(int row, int col, float v, float) const {
        const int k2 = col % DGD, bg = col / DGD, g = bg % DGROUPS, b = bg / DGROUPS;
        A3[(size_t)(b * SEQ + row) * DM + CWD + g * DGD + k2] = f2bf(v * (1.f / 512.f));
    }
};
struct EpMoe2 { float* O; const float* gate; DEV void operator()(int row, int col, float v, float) const { O[(size_t)row * DM + col] += gate[row] * v; } };

__global__ void k_conv4(const bf16* __restrict__ XA_RAW, const float* __restrict__ w, const float* __restrict__ b, float* __restrict__ XA) {
    const int idx = blockIdx.x * blockDim.x + threadIdx.x;
    if (idx >= NROWS * AW) return;
    const int ch = idx % AW, row = idx / AW;
    int seg0, seglen;
    if (row < NTOK) { seg0 = (row / SEQ) * SEQ; seglen = SEQ; } else { seg0 = NTOK + ((row - NTOK) / CTXL) * CTXL; seglen = CTXL; }
    const int t = row - seg0;
    float acc = b[ch];
#pragma unroll
    for (int j = 0; j < 4; ++j) { const int tt = t + j - 1; if (tt >= 0 && tt < seglen) acc += w[j * AW + ch] * bf2f(XA_RAW[(size_t)(seg0 + tt) * AW + ch]); }
    XA[idx] = acc;
}
__global__ void __launch_bounds__(64) k_scan(const float* __restrict__ XA, const float* __restrict__ w_r, const float* __restrict__ b_r, const float* __restrict__ w_i,
                                              const float* __restrict__ b_i, const float* __restrict__ lam, const bf16* __restrict__ GA, float* __restrict__ HSUM,
                                              bf16* __restrict__ A2, int dir) {
    const int h = blockIdx.x % AHEADS, b = blockIdx.x / AHEADS, e = threadIdx.x, ch = h * AHD + e;
    const float* wr = w_r + (size_t)((dir * AHEADS + h) * AHD) * AHD;
    const float* wi = w_i + (size_t)((dir * AHEADS + h) * AHD) * AHD;
    float wrv[AHD], wiv[AHD];
#pragma unroll
    for (int d = 0; d < AHD; ++d) { wrv[d] = wr[d * AHD + e]; wiv[d] = wi[d * AHD + e]; }
    const float br = b_r[dir * AW + ch], bi = b_i[dir * AW + ch];
    const float sp = softplus_f(-lam[dir * AW + ch]);
    float state = 0.f;
    for (int step = 0; step < CTXL + SEQ; ++step) {
        const bool isctx = step < CTXL;
        int t = isctx ? step : step - CTXL;
        if (dir) t = (isctx ? CTXL : SEQ) - 1 - t;
        const int row = isctx ? NTOK + b * CTXL + t : b * SEQ + t;
        const float* xr = XA + (size_t)row * AW + h * AHD;
        float r = br, i = bi;
#pragma unroll
        for (int d = 0; d < AHD; ++d) { const float xv = xr[d]; r += xv * wrv[d]; i += xv * wiv[d]; }
        r = sigmoid_f(r); i = sigmoid_f(i);
        const float la = -8.f * r * sp;
        const float a = expf(la);
        const float bb = sqrtf(-expm1f(2.f * la)) * (i * xr[e]);
        state = a * state + bb;
        if (!isctx) {
            if (dir == 0) HSUM[(size_t)row * AW + ch] = state;
            else A2[(size_t)row * DM + ch] = f2bf((HSUM[(size_t)row * AW + ch] + state) * bf2f(GA[(size_t)row * AW + ch]));
        }
    }
}
__global__ void k_conv31(const bf16* __restrict__ GLU, const float* __restrict__ w, const float* __restrict__ b, float* __restrict__ U31) {
    const int idx = blockIdx.x * blockDim.x + threadIdx.x;
    if (idx >= NTOK * BWD) return;
    const int ch = idx % BWD, row = idx / BWD, seg0 = (row / SEQ) * SEQ, t = row - seg0;
    float acc = b[ch];
    for (int j = 0; j < CONVB; ++j) { const int tt = t + j - 15; if (tt >= 0 && tt < SEQ) acc += w[j * BWD + ch] * bf2f(GLU[(size_t)(seg0 + tt) * BWD + ch]); }
    U31[idx] = acc;
}
__global__ void __launch_bounds__(256) k_ln_silu(const float* __restrict__ U31, const float* __restrict__ g, const float* __restrict__ bb, bf16* __restrict__ A2) {
    __shared__ float sm[4];
    const int row = blockIdx.x, tid = threadIdx.x;
    const float v0 = U31[(size_t)row * BWD + tid], v1 = U31[(size_t)row * BWD + 256 + tid];
    const float mu = block_sum<4>(v0 + v1, sm) * (1.f / BWD);
    const float d0 = v0 - mu, d1 = v1 - mu;
    const float var = block_sum<4>(d0 * d0 + d1 * d1, sm) * (1.f / BWD);
    const float rs = rsqrtf(var + LN_EPS);
    A2[(size_t)row * DM + BWD + tid] = f2bf(silu_f(d0 * rs * g[tid] + bb[tid]));
    A2[(size_t)row * DM + BWD + 256 + tid] = f2bf(silu_f(d1 * rs * g[256 + tid] + bb[256 + tid]));
}
template <class T> DEV float ldval(const T* p);
template <> DEV float ldval<bf16>(const bf16* p) { return bf2f(*p); }
template <> DEV float ldval<float>(const float* p) { return *p; }
template <class T>
__global__ void __launch_bounds__(256) k_resid(const T* __restrict__ Y, float* __restrict__ X, const float* __restrict__ gpost, const float* __restrict__ ADAl, int g_off) {
    __shared__ float sm[4];
    const int row = blockIdx.x, tid = threadIdx.x, b = row / SEQ;
    float y[4]; float ss = 0.f;
#pragma unroll
    for (int i = 0; i < 4; ++i) { y[i] = ldval<T>(Y + (size_t)row * DM + tid * 4 + i); ss += y[i] * y[i]; }
    const float r = rsqrtf(block_sum<4>(ss, sm) * (1.f / DM) + NORM_EPS);
#pragma unroll
    for (int i = 0; i < 4; ++i) { const int d = tid * 4 + i; X[(size_t)row * DM + d] += ADAl[(size_t)b * 6 * DM + g_off + d] * (y[i] * r * gpost[d]); }
}

__global__ void __launch_bounds__(256) k_ln_v(const bf16* __restrict__ V, const float* __restrict__ g, const float* __restrict__ bb, float* __restrict__ VLN) {
    __shared__ float sm[4];
    const int row = blockIdx.x, tid = threadIdx.x;
    const float v0 = bf2f(V[(size_t)row * CWD + tid]), v1 = bf2f(V[(size_t)row * CWD + 256 + tid]);
    const float mu = block_sum<4>(v0 + v1, sm) * (1.f / CWD);
    const float d0 = v0 - mu, d1 = v1 - mu;
    const float rs = rsqrtf(block_sum<4>(d0 * d0 + d1 * d1, sm) * (1.f / CWD) + LN_EPS);
    VLN[(size_t)row * CWD + tid] = d0 * rs * g[tid] + bb[tid];
    VLN[(size_t)row * CWD + 256 + tid] = d1 * rs * g[256 + tid] + bb[256 + tid];
}
__global__ void k_sgate(const bf16* __restrict__ U, const float* __restrict__ VLN, const float* __restrict__ w_s, const float* __restrict__ b_s, bf16* __restrict__ A3) {
    const int idx = blockIdx.x * blockDim.x + threadIdx.x;
    if (idx >= NTOK * CWD) return;
    const int ch = idx % CWD, row = idx / CWD, h = ch / CHD, p = row % CHUNK, base = row - p;
    const float* ws = w_s + (size_t)(h * CHUNK + p) * CHUNK;
    float acc = b_s[h * CHUNK + p];
    for (int q = 0; q < CHUNK; ++q) acc += ws[q] * VLN[(size_t)(base + q) * CWD + ch];
    A3[(size_t)row * DM + ch] = f2bf(bf2f(U[(size_t)row * CWD + ch]) * acc);
}
__global__ void k_chandft(const bf16* __restrict__ F, bf16* __restrict__ ZT) {
    const int idx = blockIdx.x * blockDim.x + threadIdx.x;
    if (idx >= NB * DGROUPS * DGD * SEQ) return;
    const int l = idx % SEQ, k2 = (idx / SEQ) % DGD, bg = idx / (SEQ * DGD), g = bg % DGROUPS, b = bg / DGROUPS;
    const bf16* f = F + (size_t)(b * SEQ + l) * DWD + g * DGD;
    float zc = 0.f, zs = 0.f;
    for (int d = 0; d < DGD; ++d) { const int m = (k2 * d) & (DGD - 1); const float ang = (float)m * (2.f / DGD); const float v = bf2f(f[d]); zc += v * cospif(ang); zs += v * sinpif(ang); }
    ZT[(size_t)(bg * DGD + k2) * (2 * SEQ) + l] = f2bf(zc);
    ZT[(size_t)(bg * DGD + k2) * (2 * SEQ) + SEQ + l] = f2bf(zs);
}
__global__ void k_dftmat(bf16* __restrict__ DFTA) {
    const int idx = blockIdx.x * blockDim.x + threadIdx.x;
    if (idx >= SEQ * SEQ) return;
    const int l = idx % SEQ, k1 = idx / SEQ, m = (k1 * l) & (SEQ - 1);
    const float ang = (float)m * (2.f / SEQ);
    DFTA[(size_t)k1 * 2 * SEQ + l] = f2bf(cospif(ang));
    DFTA[(size_t)k1 * 2 * SEQ + SEQ + l] = f2bf(-sinpif(ang));
}
__global__ void __launch_bounds__(256) k_norm_mod_route(const float* __restrict__ X, bf16* __restrict__ H, const float* __restrict__ gain, const float* __restrict__ ADAl,
                                                         int sh_off, int sc_off, const float* __restrict__ router, float* __restrict__ GATE) {
    __shared__ float sm[4];
    const int row = blockIdx.x, tid = threadIdx.x, b = row / SEQ;
    const float4 v = *(const float4*)(X + (size_t)row * DM + tid * 4);
    const float ss = block_sum<4>(v.x * v.x + v.y * v.y + v.z * v.z + v.w * v.w, sm);
    const float r = rsqrtf(ss * (1.f / DM) + NORM_EPS);
    const float* a = ADAl + (size_t)b * 6 * DM;
    const float xs[4] = {v.x, v.y, v.z, v.w};
    float lg[NE];
#pragma unroll
    for (int e = 0; e < NE; ++e) lg[e] = 0.f;
#pragma unroll
    for (int i = 0; i < 4; ++i) {
        const int d = tid * 4 + i;
        const float h = (xs[i] * r * gain[d]) * (1.f + a[sc_off + d]) + a[sh_off + d];
        H[(size_t)row * DM + d] = f2bf(h);
#pragma unroll
        for (int e = 0; e < NE; ++e) lg[e] += h * router[d * NE + e];
    }
#pragma unroll
    for (int e = 0; e < NE; ++e) lg[e] = block_sum<4>(lg[e], sm);
    if (tid == 0) {
        int i1 = 0; float v1 = lg[0];
#pragma unroll
        for (int e = 1; e < NE; ++e) if (lg[e] > v1) { v1 = lg[e]; i1 = e; }
        int i2 = -1; float v2 = -3.0e38f;
#pragma unroll
        for (int e = 0; e < NE; ++e) if (e != i1 && lg[e] > v2) { v2 = lg[e]; i2 = e; }
        const float p2 = 1.f / (1.f + expf(v1 - v2)), p1 = 1.f - p2;
#pragma unroll
        for (int e = 0; e < NE; ++e) GATE[(size_t)e * NTOK + row] = (e == i1) ? p1 : ((e == i2) ? p2 : 0.f);
    }
}

constexpr size_t MiB = 1u << 20;
constexpr size_t WS_CTL = 0, WS_ADA = 1 * MiB, WS_GATE = 2 * MiB;
constexpr size_t WS_WIN0 = 4 * MiB, WS_WOUT0 = 8 * MiB, WS_W13 = 10 * MiB, WS_W2 = 21 * MiB, WS_CDIN = 27 * MiB, WS_CDOUT = 30 * MiB, WS_DFTA = 32 * MiB;
constexpr size_t WS_MW13 = 48 * MiB, WS_MW2 = 160 * MiB, WS_H = 216 * MiB, WS_AR = 252 * MiB, WS_END = 448 * MiB;

static inline unsigned cdiv(size_t a, size_t b) { return (unsigned)((a + b - 1) / b); }

extern "C" void kernel_launch(void* const* d_in, const int* in_sizes, int n_in, void* d_out, int out_size, void* d_ws, size_t ws_size, hipStream_t stream) {
    if (n_in != 33 || ws_size < WS_END) { fprintf(stderr, "kernel_launch: unexpected n_in %d / ws_size %zu\n", n_in, ws_size); return; }
    const float* x = (const float*)d_in[0]; const float* c = (const float*)d_in[1]; const float* ctx = (const float*)d_in[2]; const float* c_ctx = (const float*)d_in[3];
    const float* ada_w = (const float*)d_in[4]; const float* ada_b = (const float*)d_in[5]; const float* norm_g = (const float*)d_in[6];
    const float* ab_w_in = (const float*)d_in[7]; const float* rg_conv_w = (const float*)d_in[8]; const float* rg_conv_b = (const float*)d_in[9];
    const float* rg_w_r = (const float*)d_in[10]; const float* rg_b_r = (const float*)d_in[11]; const float* rg_w_i = (const float*)d_in[12]; const float* rg_b_i = (const float*)d_in[13];
    const float* rg_lambda = (const float*)d_in[14]; const float* cv_dw_w = (const float*)d_in[15]; const float* cv_dw_b = (const float*)d_in[16];
    const float* cv_ln_g = (const float*)d_in[17]; const float* cv_ln_b = (const float*)d_in[18]; const float* ab_w_out = (const float*)d_in[19];
    const float* ffn_w1 = (const float*)d_in[20]; const float* ffn_w3 = (const float*)d_in[21]; const float* ffn_w2 = (const float*)d_in[22];
    const float* cd_w_in = (const float*)d_in[23]; const float* sg_ln_g = (const float*)d_in[24]; const float* sg_ln_b = (const float*)d_in[25];
    const float* sg_w_s = (const float*)d_in[26]; const float* sg_b_s = (const float*)d_in[27]; const float* cd_w_out = (const float*)d_in[28];
    const float* moe_router = (const float*)d_in[29]; const float* moe_w1 = (const float*)d_in[30]; const float* moe_w3 = (const float*)d_in[31]; const float* moe_w2 = (const float*)d_in[32];
    float* X = (float*)d_out;
    unsigned char* ws = (unsigned char*)d_ws;
    float* ADA = (float*)(ws + WS_ADA); float* GATE = (float*)(ws + WS_GATE);
    bf16* WIN0 = (bf16*)(ws + WS_WIN0); bf16* WOUT0 = (bf16*)(ws + WS_WOUT0); bf16* W13 = (bf16*)(ws + WS_W13); bf16* W2 = (bf16*)(ws + WS_W2);
    bf16* CDIN = (bf16*)(ws + WS_CDIN); bf16* CDOUT = (bf16*)(ws + WS_CDOUT); bf16* DFTA = (bf16*)(ws + WS_DFTA); bf16* MW13 = (bf16*)(ws + WS_MW13); bf16* MW2 = (bf16*)(ws + WS_MW2);
    bf16* H = (bf16*)(ws + WS_H);
    unsigned char* ar = ws + WS_AR;
    bf16* Y = (bf16*)(ar);
    bf16* XA_RAW = (bf16*)(ar + 32 * MiB);
    bf16* GA = (bf16*)(ar + 50 * MiB);
    bf16* GLU = (bf16*)(ar + 66 * MiB);
    bf16* A2 = (bf16*)(ar + 82 * MiB);
    float* XA = (float*)(ar + 114 * MiB);
    float* HSUM = (float*)(ar + 150 * MiB);
    float* U31 = (float*)(ar + 0 * MiB);
    bf16* ACT = (bf16*)(ar + 32 * MiB);
    bf16* U = (bf16*)(ar + 32 * MiB); bf16* V = (bf16*)(ar + 48 * MiB); bf16* F = (bf16*)(ar + 64 * MiB);
    bf16* A3 = (bf16*)(ar + 80 * MiB);
    float* VLN = (float*)(ar + 112 * MiB);
    bf16* ZT = (bf16*)(ar + 144 * MiB);
    float* OUTMOE = (float*)(ar + 0 * MiB);
    bf16* ACTE = (bf16*)(ar + 64 * MiB);

    const float* ADA0 = ADA; const float* ADA1 = ADA + 9 * 6 * DM;
    k_ada<<<cdiv(2 * 9 * 6 * DM, 256), 256, 0, stream>>>(c, c_ctx, ada_w, ada_b, ADA);
    k_posadd<<<cdiv((size_t)NTOK * DM, 256), 256, 0, stream>>>(x, X);
    auto wt = [&](const float* W, int ldw, int col0, int ncols, int K, bf16* Wt, int row_off, int mode, int half) {
        k_wt<<<cdiv((size_t)ncols * K, 256), 256, 0, stream>>>(W, ldw, col0, ncols, K, Wt, row_off, mode, half);
    };
    wt(ab_w_in, 2048, 0, 1024, DM, WIN0, 0, 0, 0);
    wt(ab_w_in, 2048, 1024, 512, DM, WIN0, 1024, 1, 0);
    wt(ab_w_in, 2048, 1536, 512, DM, WIN0, 1024, 1, 1);
    wt(ab_w_out, DM, 0, DM, DM, WOUT0, 0, 0, 0);
    wt(ffn_w1, DFF, 0, DFF, DM, W13, 0, 1, 0);
    wt(ffn_w3, DFF, 0, DFF, DM, W13, 0, 1, 1);
    wt(ffn_w2, DM, 0, DM, DFF, W2, 0, 0, 0);
    wt(cd_w_in, 1536, 0, 1536, DM, CDIN, 0, 0, 0);
    wt(cd_w_out, DM, 0, DM, DM, CDOUT, 0, 0, 0);
    for (int e = 0; e < NE; ++e) {
        wt(moe_w1 + (size_t)e * DM * DFE, DFE, 0, DFE, DM, MW13 + (size_t)e * 2 * DFE * DM, 0, 1, 0);
        wt(moe_w3 + (size_t)e * DM * DFE, DFE, 0, DFE, DM, MW13 + (size_t)e * 2 * DFE * DM, 0, 1, 1);
        wt(moe_w2 + (size_t)e * DFE * DM, DM, 0, DM, DFE, MW2 + (size_t)e * DM * DFE, 0, 0, 0);
    }
    k_dftmat<<<cdiv((size_t)SEQ * SEQ, 256), 256, 0, stream>>>(DFTA);

    const float* ng0 = norm_g;
    k_norm_mod<<<NTOK, 256, 0, stream>>>(X, H, SEQ, ng0 + 0 * DM, ADA0, 0 * DM, 1 * DM, -1);
    k_norm_mod<<<NCTX, 256, 0, stream>>>(ctx, H + (size_t)NTOK * DM, CTXL, ng0 + 0 * DM, ADA0, 0 * DM, 1 * DM, 8);
    k_gemm<false, EpIn0><<<dim3(1024 / 64, NROWS / 32), 256, 0, stream>>>(H, WIN0, DM, nullptr, EpIn0{XA_RAW, GA});
    k_gemm<true, EpGlu><<<dim3(512 / 64, NTOK / 32), 256, 0, stream>>>(H, WIN0 + (size_t)1024 * DM, DM, nullptr, EpGlu{GLU, BWD, 0});
    k_conv4<<<cdiv((size_t)NROWS * AW, 256), 256, 0, stream>>>(XA_RAW, rg_conv_w, rg_conv_b, XA);
    k_scan<<<NB * AHEADS, 64, 0, stream>>>(XA, rg_w_r, rg_b_r, rg_w_i, rg_b_i, rg_lambda, GA, HSUM, A2, 0);
    k_scan<<<NB * AHEADS, 64, 0, stream>>>(XA, rg_w_r, rg_b_r, rg_w_i, rg_b_i, rg_lambda, GA, HSUM, A2, 1);
    k_conv31<<<cdiv((size_t)NTOK * BWD, 256), 256, 0, stream>>>(GLU, cv_dw_w, cv_dw_b, U31);
    k_ln_silu<<<NTOK, 256, 0, stream>>>(U31, cv_ln_g, cv_ln_b, A2);
    k_gemm<false, EpPlainBf16><<<dim3(DM / 64, NTOK / 32), 256, 0, stream>>>(A2, WOUT0, DM, nullptr, EpPlainBf16{Y, DM, 0});
    k_resid<bf16><<<NTOK, 256, 0, stream>>>(Y, X, ng0 + 1 * DM, ADA0, 2 * DM);
    k_norm_mod<<<NTOK, 256, 0, stream>>>(X, H, SEQ, ng0 + 2 * DM, ADA0, 3 * DM, 4 * DM, -1);
    k_gemm<true, EpSwiglu><<<dim3(DFF / 64, NTOK / 32), 256, 0, stream>>>(H, W13, DM, nullptr, EpSwiglu{ACT, DFF, 0});
    k_gemm<false, EpPlainBf16><<<dim3(DM / 64, NTOK / 32), 256, 0, stream>>>(ACT, W2, DFF, nullptr, EpPlainBf16{Y, DM, 0});
    k_resid<bf16><<<NTOK, 256, 0, stream>>>(Y, X, ng0 + 3 * DM, ADA0, 5 * DM);

    const float* ng1 = norm_g + 4 * DM;
    k_norm_mod<<<NTOK, 256, 0, stream>>>(X, H, SEQ, ng1 + 0 * DM, ADA1, 0 * DM, 1 * DM, -1);
    k_gemm<false, EpIn1><<<dim3(1536 / 64, NTOK / 32), 256, 0, stream>>>(H, CDIN, DM, nullptr, EpIn1{U, V, F});
    k_ln_v<<<NTOK, 256, 0, stream>>>(V, sg_ln_g, sg_ln_b, VLN);
    k_sgate<<<cdiv((size_t)NTOK * CWD, 256), 256, 0, stream>>>(U, VLN, sg_w_s, sg_b_s, A3);
    k_chandft<<<cdiv((size_t)NB * DGROUPS * DGD * SEQ, 256), 256, 0, stream>>>(F, ZT);
    k_gemm<false, EpDft><<<dim3(4096 / 64, SEQ / 32), 256, 0, stream>>>(DFTA, ZT, 2 * SEQ, nullptr, EpDft{A3});
    k_gemm<false, EpPlainBf16><<<dim3(DM / 64, NTOK / 32), 256, 0, stream>>>(A3, CDOUT, DM, nullptr, EpPlainBf16{Y, DM, 0});
    k_resid<bf16><<<NTOK, 256, 0, stream>>>(Y, X, ng1 + 1 * DM, ADA1, 2 * DM);
    k_norm_mod_route<<<NTOK, 256, 0, stream>>>(X, H, ng1 + 2 * DM, ADA1, 3 * DM, 4 * DM, moe_router, GATE);
    (void)hipMemsetAsync(OUTMOE, 0, (size_t)NTOK * DM * 4, stream);
    for (int e = 0; e < NE; ++e) {
        const float* gate = GATE + (size_t)e * NTOK;
        k_gemm<true, EpSwiglu><<<dim3(DFE / 64, NTOK / 32), 256, 0, stream>>>(H, MW13 + (size_t)e * 2 * DFE * DM, DM, gate, EpSwiglu{ACTE, DFE, 0});
        k_gemm<false, EpMoe2><<<dim3(DM / 64, NTOK / 32), 256, 0, stream>>>(ACTE, MW2 + (size_t)e * DM * DFE, DFE, gate, EpMoe2{OUTMOE, gate});
    }
    k_resid<float><<<NTOK, 256, 0, stream>>>(OUTMOE, X, ng1 + 3 * DM, ADA1, 5 * DM);
}
```

```cpp
#include <hip/hip_runtime.h>
#include <cstdint>
#include <cstdio>

typedef unsigned short bf16;
#define DEV __device__ __forceinline__

constexpr int NB = 8, SEQ = 2048, DM = 1024, CTXL = 256, GRIDW = 64;
constexpr int NTOK = NB * SEQ;
constexpr int NCTX = NB * CTXL;
constexpr int NROWS = NTOK + NCTX;
constexpr int AW = 512, AHEADS = 8, AHD = 64, BWD = 512, CONVB = 31;
constexpr int CWD = 512, CHEADS = 8, CHD = 64, CHUNK = 128, DWD = 512, DGROUPS = 4, DGD = 128;
constexpr int DFF = 2816, NE = 8, DFE = 3584;
constexpr float NORM_EPS = 1e-6f, LN_EPS = 1e-5f;

DEV float bf2f(bf16 h) { return __uint_as_float((unsigned)h << 16); }
DEV bf16 f2bf(float f) { unsigned u = __float_as_uint(f); return (bf16)((u + 0x7fffu + ((u >> 16) & 1u)) >> 16); }
DEV float sigmoid_f(float x) { return 1.f / (1.f + expf(-x)); }
DEV float silu_f(float x) { return x * sigmoid_f(x); }
DEV float gelu_tanh_f(float x) { const float u = 0.7978845608028654f * (x + 0.044715f * x * x * x); return 0.5f * x * (1.f + tanhf(u)); }
DEV float softplus_f(float x) { return x > 20.f ? x : log1pf(expf(x)); }
DEV float wave_sum(float v) {
#pragma unroll
    for (int o = 32; o > 0; o >>= 1) v += __shfl_xor(v, o);
    return v;
}
template <int NW> DEV float block_sum(float v, float* sm) {
    v = wave_sum(v);
    __syncthreads();
    if ((threadIdx.x & 63) == 0) sm[threadIdx.x >> 6] = v;
    __syncthreads();
    float t = 0.f;
#pragma unroll
    for (int i = 0; i < NW; ++i) t += sm[i];
    return t;
}

__global__ void k_ada(const float* __restrict__ c, const float* __restrict__ cctx, const float* __restrict__ ada_w, const float* __restrict__ ada_b, float* __restrict__ ADA) {
    const int idx = blockIdx.x * blockDim.x + threadIdx.x;
    if (idx >= 2 * 9 * 6 * DM) return;
    const int j = idx % (6 * DM), r = (idx / (6 * DM)) % 9, l = idx / (6 * DM * 9);
    const float* src = r < 8 ? c + r * DM : cctx;
    const float* w = ada_w + (size_t)l * DM * 6 * DM + j;
    float acc = ada_b[l * 6 * DM + j];
    for (int k = 0; k < DM; ++k) acc += silu_f(src[k]) * w[(size_t)k * 6 * DM];
    ADA[idx] = acc;
}

__global__ void k_posadd(const float* __restrict__ x, float* __restrict__ X) {
    const size_t idx = (size_t)blockIdx.x * blockDim.x + threadIdx.x;
    if (idx >= (size_t)NTOK * DM) return;
    const int d = (int)(idx % DM), t = (int)((idx / DM) % SEQ);
    const int q = d / 256, f = d % 256;
    const float omega = powf(10000.f, -(float)f / 256.f);
    const float pos = (q < 2) ? (float)(t / GRIDW) : (float)(t % GRIDW);
    const float ang = pos * omega;
    const float pe = (q & 1) ? cosf(ang) : sinf(ang);
    X[idx] = x[idx] + pe;
}

__global__ void __launch_bounds__(256) k_norm_mod(const float* __restrict__ Xin, bf16* __restrict__ H, int rows_per_batch, const float* __restrict__ gain,
                                                   const float* __restrict__ ADAl, int sh_off, int sc_off, int fixed_row) {
    __shared__ float sm[4];
    const int row = blockIdx.x, tid = threadIdx.x;
    const int arow = fixed_row >= 0 ? fixed_row : row / rows_per_batch;
    const float4 v = *(const float4*)(Xin + (size_t)row * DM + tid * 4);
    const float ss = block_sum<4>(v.x * v.x + v.y * v.y + v.z * v.z + v.w * v.w, sm);
    const float r = rsqrtf(ss * (1.f / DM) + NORM_EPS);
    const float* a = ADAl + (size_t)arow * 6 * DM;
    const float xs[4] = {v.x, v.y, v.z, v.w};
#pragma unroll
    for (int i = 0; i < 4; ++i) {
        const int d = tid * 4 + i;
        const float h = (xs[i] * r * gain[d]) * (1.f + a[sc_off + d]) + a[sh_off + d];
        H[(size_t)row * DM + d] = f2bf(h);
    }
}

__global__ void k_wt(const float* __restrict__ W, int ldw, int col0, int ncols, int K, bf16* __restrict__ Wt, int row_off, int mode, int half) {
    const size_t idx = (size_t)blockIdx.x * blockDim.x + threadIdx.x;
    if (idx >= (size_t)ncols * K) return;
    const int n = (int)(idx % ncols), k = (int)(idx / ncols);
    const int nm = mode ? (n / 128) * 256 + half * 128 + (n % 128) : n;
    Wt[(size_t)(row_off + nm) * K + k] = f2bf(W[(size_t)k * ldw + col0 + n]);
}

DEV void unpack8(const uint4 v, float* f) {
    f[0] = __uint_as_float(v.x << 16); f[1] = __uint_as_float(v.x & 0xffff0000u);
    f[2] = __uint_as_float(v.y << 16); f[3] = __uint_as_float(v.y & 0xffff0000u);
    f[4] = __uint_as_float(v.z << 16); f[5] = __uint_as_float(v.z & 0xffff0000u);
    f[6] = __uint_as_float(v.w << 16); f[7] = __uint_as_float(v.w & 0xffff0000u);
}
template <bool PAIRED, class Epi>
__global__ void __launch_bounds__(256) k_gemm(const bf16* __restrict__ A, const bf16* __restrict__ Bt, int K, const float* __restrict__ rowgate, Epi epi) {
    const int lane = threadIdx.x & 63, rg = threadIdx.x >> 6;
    const int L = blockIdx.x * 64 + lane;
    const int r0 = blockIdx.y * 32 + rg * 8;
    const int n0 = PAIRED ? (L / 128) * 256 + (L % 128) : L;
    const bf16* b0 = Bt + (size_t)n0 * K;
    const bf16* b1 = b0 + (size_t)128 * K;
    float acc0[8], acc1[8];
    bool act[8];
    bool any = false;
#pragma unroll
    for (int i = 0; i < 8; ++i) { acc0[i] = 0.f; acc1[i] = 0.f; act[i] = rowgate ? (rowgate[r0 + i] != 0.f) : true; any |= act[i]; }
    if (!any) return;
    for (int k = 0; k < K; k += 8) {
        float fb0[8], fb1[8];
        unpack8(*(const uint4*)(b0 + k), fb0);
        if (PAIRED) unpack8(*(const uint4*)(b1 + k), fb1);
#pragma unroll
        for (int i = 0; i < 8; ++i) {
            if (act[i]) {
                float fa[8];
                unpack8(*(const uint4*)(A + (size_t)(r0 + i) * K + k), fa);
#pragma unroll
                for (int j = 0; j < 8; ++j) { acc0[i] += fa[j] * fb0[j]; if (PAIRED) acc1[i] += fa[j] * fb1[j]; }
            }
        }
    }
#pragma unroll
    for (int i = 0; i < 8; ++i) if (act[i]) epi(r0 + i, L, acc0[i], acc1[i]);
}

struct EpIn0 {
    bf16* XA_RAW; bf16* GA;
    DEV void operator()(int row, int col, float v, float) const {
        if (col < AW) XA_RAW[(size_t)row * AW + col] = f2bf(v);
        else if (row < NTOK) GA[(size_t)row * AW + (col - AW)] = f2bf(gelu_tanh_f(v));
    }
};
struct EpGlu { bf16* O; int ldc; int pad; DEV void operator()(int row, int col, float v0, float v1) const { O[(size_t)row * ldc + col] = f2bf(v0 * sigmoid_f(v1)); } };
struct EpSwiglu { bf16* O; int ldc; int pad; DEV void operator()(int row, int col, float v0, float v1) const { O[(size_t)row * ldc + col] = f2bf(silu_f(v0) * v1); } };
struct EpPlainBf16 { bf16* O; int ldc; int pad; DEV void operator()(int row, int col, float v, float) const { O[(size_t)row * ldc + col] = f2bf(v); } };
struct EpIn1 {
    bf16* U; bf16* V; bf16* F;
    DEV void operator()(int row, int col, float v, float) const {
        if (col < CWD) U[(size_t)row * CWD + col] = f2bf(gelu_tanh_f(v));
        else if (col < 2 * CWD) V[(size_t)row * CWD + (col - CWD)] = f2bf(gelu_tanh_f(v));
        else F[(size_t)row * DWD + (col - 2 * CWD)] = f2bf(v);
    }
};
struct EpDft {
    bf16* A3;
    DEV void operator()(int row, int col, float v, float) const {
        const int k2 = col % DGD, bg = col / DGD, g = bg % DGROUPS, b = bg / DGROUPS;
        A3[(size_t)(b * SEQ + row) * DM + CWD + g * DGD + k2] = f2bf(v * (1.f / 512.f));
    }
};
struct EpMoe2 { float* O; const float* gate; DEV void operator()(int row, int col, float v, float) const { O[(size_t)row * DM + col] += gate[row] * v; } };

__global__ void k_conv4(const bf16* __restrict__ XA_RAW, const float* __restrict__ w, const float* __restrict__ b, float* __restrict__ XA) {
    const int idx = blockIdx.x * blockDim.x + threadIdx.x;
    if (idx >= NROWS * AW) return;
    const int ch = idx % AW, row = idx / AW;
    int seg0, seglen;
    if (row < NTOK) { seg0 = (row / SEQ) * SEQ; seglen = SEQ; } else { seg0 = NTOK + ((row - NTOK) / CTXL) * CTXL; seglen = CTXL; }
    const int t = row - seg0;
    float acc = b[ch];
#pragma unroll
    for (int j = 0; j < 4; ++j) { const int tt = t + j - 1; if (tt >= 0 && tt < seglen) acc += w[j * AW + ch] * bf2f(XA_RAW[(size_t)(seg0 + tt) * AW + ch]); }
    XA[idx] = acc;
}
__global__ void __launch_bounds__(64) k_scan(const float* __restrict__ XA, const float* __restrict__ w_r, const float* __restrict__ b_r, const float* __restrict__ w_i,
                                              const float* __restrict__ b_i, const float* __restrict__ lam, const bf16* __restrict__ GA, float* __restrict__ HSUM,
                                              bf16* __restrict__ A2, int dir) {
    const int h = blockIdx.x % AHEADS, b = blockIdx.x / AHEADS, e = threadIdx.x, ch = h * AHD + e;
    const float* wr = w_r + (size_t)((dir * AHEADS + h) * AHD) * AHD;
    const float* wi = w_i + (size_t)((dir * AHEADS + h) * AHD) * AHD;
    float wrv[AHD], wiv[AHD];
#pragma unroll
    for (int d = 0; d < AHD; ++d) { wrv[d] = wr[d * AHD + e]; wiv[d] = wi[d * AHD + e]; }
    const float br = b_r[dir * AW + ch], bi = b_i[dir * AW + ch];
    const float sp = softplus_f(-lam[dir * AW + ch]);
    float state = 0.f;
    for (int step = 0; step < CTXL + SEQ; ++step) {
        const bool isctx = step < CTXL;
        int t = isctx ? step : step - CTXL;
        if (dir) t = (isctx ? CTXL : SEQ) - 1 - t;
        const int row = isctx ? NTOK + b * CTXL + t : b * SEQ + t;
        const float* xr = XA + (size_t)row * AW + h * AHD;
        float r = br, i = bi;
#pragma unroll
        for (int d = 0; d < AHD; ++d) { const float xv = xr[d]; r += xv * wrv[d]; i += xv * wiv[d]; }
        r = sigmoid_f(r); i = sigmoid_f(i);
        const float la = -8.f * r * sp;
        const float a = expf(la);
        const float bb = sqrtf(-expm1f(2.f * la)) * (i * xr[e]);
        state = a * state + bb;
        if (!isctx) {
            if (dir == 0) HSUM[(size_t)row * AW + ch] = state;
            else A2[(size_t)row * DM + ch] = f2bf((HSUM[(size_t)row * AW + ch] + state) * bf2f(GA[(size_t)row * AW + ch]));
        }
    }
}
__global__ void k_conv31(const bf16* __restrict__ GLU, const float* __restrict__ w, const float* __restrict__ b, float* __restrict__ U31) {
    const int idx = blockIdx.x * blockDim.x + threadIdx.x;
    if (idx >= NTOK * BWD) return;
    const int ch = idx % BWD, row = idx / BWD, seg0 = (row / SEQ) * SEQ, t = row - seg0;
    float acc = b[ch];
    for (int j = 0; j < CONVB; ++j) { const int tt = t + j - 15; if (tt >= 0 && tt < SEQ) acc += w[j * BWD + ch] * bf2f(GLU[(size_t)(seg0 + tt) * BWD + ch]); }
    U31[idx] = acc;
}
__global__ void __launch_bounds__(256) k_ln_silu(const float* __restrict__ U31, const float* __restrict__ g, const float* __restrict__ bb, bf16* __restrict__ A2) {
    __shared__ float sm[4];
    const int row = blockIdx.x, tid = threadIdx.x;
    const float v0 = U31[(size_t)row * BWD + tid], v1 = U31[(size_t)row * BWD + 256 + tid];
    const float mu = block_sum<4>(v0 + v1, sm) * (1.f / BWD);
    const float d0 = v0 - mu, d1 = v1 - mu;
    const float var = block_sum<4>(d0 * d0 + d1 * d1, sm) * (1.f / BWD);
    const float rs = rsqrtf(var + LN_EPS);
    A2[(size_t)row * DM + BWD + tid] = f2bf(silu_f(d0 * rs * g[tid] + bb[tid]));
    A2[(size_t)row * DM + BWD + 256 + tid] = f2bf(silu_f(d1 * rs * g[256 + tid] + bb[256 + tid]));
}
template <class T> DEV float ldval(const T* p);
template <> DEV float ldval<bf16>(const bf16* p) { return bf2f(*p); }
template <> DEV float ldval<float>(const float* p) { return *p; }
template <class T>
__global__ void __launch_bounds__(256) k_resid(const T* __restrict__ Y, float* __restrict__ X, const float* __restrict__ gpost, const float* __restrict__ ADAl, int g_off) {
    __shared__ float sm[4];
    const int row = blockIdx.x, tid = threadIdx.x, b = row / SEQ;
    float y[4]; float ss = 0.f;
#pragma unroll
    for (int i = 0; i < 4; ++i) { y[i] = ldval<T>(Y + (size_t)row * DM + tid * 4 + i); ss += y[i] * y[i]; }
    const float r = rsqrtf(block_sum<4>(ss, sm) * (1.f / DM) + NORM_EPS);
#pragma unroll
    for (int i = 0; i < 4; ++i) { const int d = tid * 4 + i; X[(size_t)row * DM + d] += ADAl[(size_t)b * 6 * DM + g_off + d] * (y[i] * r * gpost[d]); }
}

__global__ void __launch_bounds__(256) k_ln_v(const bf16* __restrict__ V, const float* __restrict__ g, const float* __restrict__ bb, float* __restrict__ VLN) {
    __shared__ float sm[4];
    const int row = blockIdx.x, tid = threadIdx.x;
    const float v0 = bf2f(V[(size_t)row * CWD + tid]), v1 = bf2f(V[(size_t)row * CWD + 256 + tid]);
    const float mu = block_sum<4>(v0 + v1, sm) * (1.f / CWD);
    const float d0 = v0 - mu, d1 = v1 - mu;
    const float rs = rsqrtf(block_sum<4>(d0 * d0 + d1 * d1, sm) * (1.f / CWD) + LN_EPS);
    VLN[(size_t)row * CWD + tid] = d0 * rs * g[tid] + bb[tid];
    VLN[(size_t)row * CWD + 256 + tid] = d1 * rs * g[256 + tid] + bb[256 + tid];
}
__global__ void k_sgate(const bf16* __restrict__ U, const float* __restrict__ VLN, const float* __restrict__ w_s, const float* __restrict__ b_s, bf16* __restrict__ A3) {
    const int idx = blockIdx.x * blockDim.x + threadIdx.x;
    if (idx >= NTOK * CWD) return;
    const int ch = idx % CWD, row = idx / CWD, h = ch / CHD, p = row % CHUNK, base = row - p;
    const float* ws = w_s + (size_t)(h * CHUNK + p) * CHUNK;
    float acc = b_s[h * CHUNK + p];
    for (int q = 0; q < CHUNK; ++q) acc += ws[q] * VLN[(size_t)(base + q) * CWD + ch];
    A3[(size_t)row * DM + ch] = f2bf(bf2f(U[(size_t)row * CWD + ch]) * acc);
}
__global__ void k_chandft(const bf16* __restrict__ F, bf16* __restrict__ ZT) {
    const int idx = blockIdx.x * blockDim.x + threadIdx.x;
    if (idx >= NB * DGROUPS * DGD * SEQ) return;
    const int l = idx % SEQ, k2 = (idx / SEQ) % DGD, bg = idx / (SEQ * DGD), g = bg % DGROUPS, b = bg / DGROUPS;
    const bf16* f = F + (size_t)(b * SEQ + l) * DWD + g * DGD;
    float zc = 0.f, zs = 0.f;
    for (int d = 0; d < DGD; ++d) { const int m = (k2 * d) & (DGD - 1); const float ang = (float)m * (2.f / DGD); const float v = bf2f(f[d]); zc += v * cospif(ang); zs += v * sinpif(ang); }
    ZT[(size_t)(bg * DGD + k2) * (2 * SEQ) + l] = f2bf(zc);
    ZT[(size_t)(bg * DGD + k2) * (2 * SEQ) + SEQ + l] = f2bf(zs);
}
__global__ void k_dftmat(bf16* __restrict__ DFTA) {
    const int idx = blockIdx.x * blockDim.x + threadIdx.x;
    if (idx >= SEQ * SEQ) return;
    const int l = idx % SEQ, k1 = idx / SEQ, m = (k1 * l) & (SEQ - 1);
    const float ang = (float)m * (2.f / SEQ);
    DFTA[(size_t)k1 * 2 * SEQ + l] = f2bf(cospif(ang));
    DFTA[(size_t)k1 * 2 * SEQ + SEQ + l] = f2bf(-sinpif(ang));
}
__global__ void __launch_bounds__(256) k_norm_mod_route(const float* __restrict__ X, bf16* __restrict__ H, const float* __restrict__ gain, const float* __restrict__ ADAl,
                                                         int sh_off, int sc_off, const float* __restrict__ router, float* __restrict__ GATE) {
    __shared__ float sm[4];
    const int row = blockIdx.x, tid = threadIdx.x, b = row / SEQ;
    const float4 v = *(const float4*)(X + (size_t)row * DM + tid * 4);
    const float ss = block_sum<4>(v.x * v.x + v.y * v.y + v.z * v.z + v.w * v.w, sm);
    const float r = rsqrtf(ss * (1.f / DM) + NORM_EPS);
    const float* a = ADAl + (size_t)b * 6 * DM;
    const float xs[4] = {v.x, v.y, v.z, v.w};
    float lg[NE];
#pragma unroll
    for (int e = 0; e < NE; ++e) lg[e] = 0.f;
#pragma unroll
    for (int i = 0; i < 4; ++i) {
        const int d = tid * 4 + i;
        const float h = (xs[i] * r * gain[d]) * (1.f + a[sc_off + d]) + a[sh_off + d];
        H[(size_t)row * DM + d] = f2bf(h);
#pragma unroll
        for (int e = 0; e < NE; ++e) lg[e] += h * router[d * NE + e];
    }
#pragma unroll
    for (int e = 0; e < NE; ++e) lg[e] = block_sum<4>(lg[e], sm);
    if (tid == 0) {
        int i1 = 0; float v1 = lg[0];
#pragma unroll
        for (int e = 1; e < NE; ++e) if (lg[e] > v1) { v1 = lg[e]; i1 = e; }
        int i2 = -1; float v2 = -3.0e38f;
#pragma unroll
        for (int e = 0; e < NE; ++e) if (e != i1 && lg[e] > v2) { v2 = lg[e]; i2 = e; }
        const float p2 = 1.f / (1.f + expf(v1 - v2)), p1 = 1.f - p2;
#pragma unroll
        for (int e = 0; e < NE; ++e) GATE[(size_t)e * NTOK + row] = (e == i1) ? p1 : ((e == i2) ? p2 : 0.f);
    }
}


#ifndef MEGA_MASK
#define MEGA_MASK 1,1,1,1,1,1,1,1,1,1,1,1,1,1,1,1,1,1,1
#endif
#ifndef MEGA_ONE_LAUNCH
#define MEGA_ONE_LAUNCH 1
#endif
#define MIX0_PHASES if (IN(3)) { mix0_local(F); } SEAM(3); if (IN(4)) { mix0_carry(F); } SEAM(4);
#define MIX1_PHASES if (IN(11)) { mix1_phase(F); } SEAM(11);
#define MOE_PHASES \
    if (IN(14)) { moe_route(F); } SEAM(14); \
    if (IN(15)) { moe_gather(F); } SEAM(15); \
    if (IN(16)) { const int* TT = (const int*)(F.ws + WS_ROUTE + RT_TT); const int ntl = TT[0]; \
        pg8::Gemm g{WSP(bf16, WS_HG), WSP(bf16, WS_MW13), ntl * 256, 2 * DFE, DM, (size_t)2 * DFE * DM * 2}; pg8::MoeOrder S; S.init(ntl * 256, 2 * DFE, F.G, (int)blockIdx.x); S.tt = TT; \
        pg8::EpiSwiglu E{WSP(bf16, WS_ACTM), DFE, 0}; \
        pg8::gemm_phase<pg8::EpiSwiglu, pg8::MoeOrder, true, true>(F.lds, g, S, E); } SEAM(16); \
    if (IN(17)) { const int* TT = (const int*)(F.ws + WS_ROUTE + RT_TT); const int ntl = TT[0]; \
        pg8::Gemm g{WSP(bf16, WS_ACTM), WSP(bf16, WS_MW2), ntl * 256, DM, DFE, (size_t)DM * DFE * 2}; pg8::MoeOrder S; S.init(ntl * 256, DM, F.G, (int)blockIdx.x); S.tt = TT; \
        pg8::EpiBf16<0> E{WSP(bf16, WS_HG), DM, nullptr, 0, 0, 1.f}; \
        pg8::gemm_phase<pg8::EpiBf16<0>, pg8::MoeOrder, true, true>(F.lds, g, S, E); } SEAM(17); \
    if (IN(18)) { moe_final(F); }

namespace pg8 {
#define PG8_LAS __attribute__((address_space(3)))
typedef unsigned short bf16_t;
typedef short bf16x8 __attribute__((ext_vector_type(8)));
typedef float f32x4 __attribute__((ext_vector_type(4)));
typedef unsigned u32x4 __attribute__((ext_vector_type(4)));
constexpr int BM = 256, BK = 64, HALF = 128, HTB = HALF * BK * 2  , STAGE_BYTES = 8 * HTB, NXCD = 8, WGM = 8;

__host__ __device__ __forceinline__ int lds_byte(int r, int c) { const int st = (r >> 4) * 2 + (c >> 5), rr = r & 15, cc = c & 31, ob = rr * 64 + cc * 2; return st * 1024 + (ob ^ (((ob >> 9) & 1) << 5)); }
__host__ __device__ __forceinline__ void stage_rc(int b, int& R, int& C) { const int st = b / 1024, sb = b % 1024, swz = sb ^ (((sb >> 9) & 1) << 5); R = (st >> 1) * 16 + swz / 64; C = (st & 1) * 32 + (swz % 64) / 2; }
__host__ __device__ __forceinline__ int perm32(int rho) { const int n = rho >> 4, i = rho & 15; return 8 * (i >> 2) + 4 * n + (i & 3); }

struct Unit { int pm, pn, e; };
struct Gemm { const bf16_t* A; const bf16_t* Bt; int M, N, K; size_t bstride; };

struct StaticOrder {
    int nM, nN, nwg, G, c;
    __host__ __device__ void init(int M, int N, int G_, int c_) { nM = M / BM; nN = N / BM; nwg = nM * nN; G = G_; c = c_; }
    __host__ __device__ bool next(int i, Unit& u) const {
        const long L = (long)i * G + c; if (L >= nwg) return false;
        int wgid = (int)L; { const int q = nwg / NXCD, r = nwg % NXCD, xcd = wgid % NXCD, off = wgid / NXCD; wgid = (xcd < r ? xcd * (q + 1) : r * (q + 1) + (xcd - r) * q) + off; }
        const int nig = WGM * nN, gid = wgid / nig, fm = gid * WGM, gsz = (nM - fm) < WGM ? (nM - fm) : WGM;
        u.pm = fm + ((wgid % nig) % gsz); u.pn = (wgid % nig) / gsz; u.e = 0; return true;
    }
    __device__ __forceinline__ void a_ready(const Unit&) const {}
    __device__ __forceinline__ void done(const Unit&) const {}
};

__device__ __forceinline__ unsigned cvt_pk_bf16(float lo, float hi) { unsigned r; asm volatile("v_cvt_pk_bf16_f32 %0, %1, %2" : "=v"(r) : "v"(lo), "v"(hi)); return r; }
typedef float f32x2 __attribute__((ext_vector_type(2)));
__device__ __forceinline__ f32x2 gelu_pk(f32x2 v) {
    const f32x2 av = __builtin_elementwise_abs(v), d = av * 0.2316418882f + 1.0f;
    f32x2 t; t.x = __builtin_amdgcn_rcpf(d.x); t.y = __builtin_amdgcn_rcpf(d.y);
    f32x2 q = t * 0.5307027145f + (-0.7265760135f); q = q * t + 0.7107068705f; q = q * t + (-0.142248368f); q = q * t + 0.127414796f; q = q * t;
    const f32x2 s = (v * v) * (-0.72134752044f);
    f32x2 e; e.x = __builtin_amdgcn_exp2f(s.x); e.y = __builtin_amdgcn_exp2f(s.y);
    const f32x2 m = v * (q * e), r = v - m;
    f32x2 o; o.x = v.x < 0.f ? m.x : r.x; o.y = v.y < 0.f ? m.y : r.y; return o;
}

template <int ACT  > struct EpiBf16 {
    static constexpr bool PERM = true, AFTER_DRAIN = false; static_assert(ACT == 0 || ACT == 1, "EpiBf16: ACT is 0 (none) or 1 (gelu_pk)");
    bf16_t* O; int ldc; const float* bias; int split_cols; size_t split_stride; float scale0;
    __device__ __forceinline__ void operator()(const f32x4 (&acc)[2][2][4][2], const Unit& u, int wr, int wc, int fr, int fq) const {
        const int row0 = u.pm * BM + wr * 64 + fr; int colt = u.pn * BM; bf16_t* base = O;
        float sc = 1.f; if (split_cols) { const int t = colt / split_cols; base += (size_t)t * split_stride; colt -= t * split_cols; if (t == 0) sc = scale0; }
        const int col0 = colt + wc * 32 + 8 * fq, bcol0 = u.pn * BM + wc * 32 + 8 * fq;
        f32x4 bv[2][2];
#pragma unroll
        for (int bj = 0; bj < 2; ++bj)
#pragma unroll
            for (int n = 0; n < 2; ++n) bv[bj][n] = bias ? *(const f32x4*)(bias + bcol0 + bj * HALF + 4 * n) : (f32x4){0.f, 0.f, 0.f, 0.f};
#pragma unroll
        for (int ai = 0; ai < 2; ++ai)
#pragma unroll
            for (int m = 0; m < 4; ++m) { bf16_t* rowp = base + (size_t)(row0 + ai * HALF + m * 16) * ldc + col0;
#pragma unroll
                for (int bj = 0; bj < 2; ++bj) { f32x4 v0 = acc[ai][bj][m][0] + bv[bj][0], v1 = acc[ai][bj][m][1] + bv[bj][1];
                    if (ACT == 1) { f32x2 a = gelu_pk((f32x2){v0[0], v0[1]}), b = gelu_pk((f32x2){v0[2], v0[3]}), c = gelu_pk((f32x2){v1[0], v1[1]}), d = gelu_pk((f32x2){v1[2], v1[3]});
                        v0 = (f32x4){a.x, a.y, b.x, b.y}; v1 = (f32x4){c.x, c.y, d.x, d.y}; }
                    v0 = v0 * sc; v1 = v1 * sc; u32x4 w; w.x = cvt_pk_bf16(v0[0], v0[1]); w.y = cvt_pk_bf16(v0[2], v0[3]); w.z = cvt_pk_bf16(v1[0], v1[1]); w.w = cvt_pk_bf16(v1[2], v1[3]);
                    *(u32x4*)(rowp + bj * HALF) = w; } }
    }
};


template <class Epi, class Sched, bool ALIGN_EPI = false, bool SP2 = false>
__device__ __forceinline__ void gemm_phase(PG8_LAS unsigned char* lds, const Gemm g, const Sched& S, const Epi& E) {
    const int tid = threadIdx.x, wid = __builtin_amdgcn_readfirstlane(tid >> 6), lane = tid & 63, wr = wid >> 2, wc = wid & 3, fr = lane & 15, fq = lane >> 4;
    const int K = g.K, nt = K / BK;
    unsigned voffA[2], voffB[2];
#pragma unroll
    for (int i = 0; i < 2; ++i) { int R, C; stage_rc(tid * 16 + i * 8192, R, C); const int Rb = Epi::PERM ? ((R & ~31) + perm32(R & 31)) : R;
        voffA[i] = (unsigned)(R * K + C) * 2u; voffB[i] = (unsigned)(Rb * K + C) * 2u; }
    const size_t kstep = (size_t)(BK * 2);
    const size_t hstep = (size_t)HALF * K * 2;
    const size_t tstep = 2 * hstep;
    const unsigned ldsw = (unsigned)wid * 1024u;
    const int aoff = lds_byte(wr * 64 + fr, fq * 8), boff = lds_byte(wc * 32 + fr, fq * 8);
#define PG8_SA(b, h) (((b) * 2 + (h)) * HTB)
#define PG8_SB(b, h) ((4 + (b) * 2 + (h)) * HTB)
#define PG8_STAGE(bufoff, gbase, voff) do { _Pragma("unroll") for (int _i = 0; _i < 2; ++_i) \
        __builtin_amdgcn_global_load_lds((const unsigned*)((const char*)(gbase) + (voff)[_i]), (PG8_LAS unsigned*)(lds + (bufoff) + ldsw + _i * 8192), 16, 0, 0); } while (0)
#define PG8_LDA(dst, b, h) do { _Pragma("unroll") for (int m = 0; m < 4; ++m) _Pragma("unroll") for (int k = 0; k < 2; ++k) dst[m][k] = *(const PG8_LAS bf16x8*)(lds + PG8_SA(b, h) + aoff + m * 2048 + k * 1024); } while (0)
#define PG8_LDB(dst, b, h) do { _Pragma("unroll") for (int n = 0; n < 2; ++n) _Pragma("unroll") for (int k = 0; k < 2; ++k) dst[n][k] = *(const PG8_LAS bf16x8*)(lds + PG8_SB(b, h) + boff + n * 2048 + k * 1024); } while (0)
#define PG8_MMA(ai, bj, At, Bt) do { __builtin_amdgcn_s_setprio(1); _Pragma("unroll") for (int m = 0; m < 4; ++m) _Pragma("unroll") for (int n = 0; n < 2; ++n) _Pragma("unroll") for (int k = 0; k < 2; ++k) \
        acc[ai][bj][m][n] = __builtin_amdgcn_mfma_f32_16x16x32_bf16(Bt[n][k], At[m][k], acc[ai][bj][m][n], 0, 0, 0); __builtin_amdgcn_s_setprio(0); } while (0)
#define PG8_WAIT_V(n) asm volatile("s_waitcnt vmcnt(" #n ")" ::: "memory")
#define PG8_WAIT_L(n) asm volatile("s_waitcnt lgkmcnt(" #n ")" ::: "memory")
#define PG8_BAR __builtin_amdgcn_s_barrier()
#define PG8_SCHED __builtin_amdgcn_sched_barrier(0)
    Unit cur, nxt; int ui = 0;
    if (!S.next(0, cur)) return;
    f32x4 acc[2][2][4][2];
#pragma unroll
    for (int a = 0; a < 2; ++a)
#pragma unroll
        for (int b = 0; b < 2; ++b)
#pragma unroll
            for (int m = 0; m < 4; ++m)
#pragma unroll
                for (int n = 0; n < 2; ++n) acc[a][b][m][n] = (f32x4){0.f, 0.f, 0.f, 0.f};
    bf16x8 At[4][2], B0[2][2], B1[2][2];
    const char* cA = (const char*)g.A + (size_t)cur.pm * tstep; const char* cB = (const char*)g.Bt + (size_t)cur.pn * tstep + (size_t)cur.e * g.bstride;
    S.a_ready(cur);
    if constexpr (SP2) {
        PG8_STAGE(PG8_SB(0, 0), cB, voffB); PG8_STAGE(PG8_SB(0, 1), cB + hstep, voffB); PG8_STAGE(PG8_SA(0, 0), cA, voffA); PG8_STAGE(PG8_SA(0, 1), cA + hstep, voffA);
        if (wr == 1) PG8_BAR;
        PG8_WAIT_V(2); PG8_BAR;
        PG8_STAGE(PG8_SB(1, 0), cB + kstep, voffB); PG8_STAGE(PG8_SA(1, 0), cA + kstep, voffA); PG8_STAGE(PG8_SB(1, 1), cB + hstep + kstep, voffB);
        PG8_WAIT_V(6); PG8_BAR;
    } else {
        PG8_STAGE(PG8_SB(0, 0), cB, voffB); PG8_STAGE(PG8_SA(0, 0), cA, voffA); PG8_STAGE(PG8_SB(0, 1), cB + hstep, voffB); PG8_STAGE(PG8_SA(0, 1), cA + hstep, voffA);
        if (wr == 1) PG8_BAR;
        PG8_WAIT_V(4); PG8_BAR;
        PG8_STAGE(PG8_SB(1, 0), cB + kstep, voffB); PG8_STAGE(PG8_SA(1, 0), cA + kstep, voffA); PG8_STAGE(PG8_SB(1, 1), cB + hstep + kstep, voffB);
        PG8_WAIT_V(6); PG8_BAR;
    }
    for (;;) {
        const bool has_next = S.next(ui + 1, nxt);
        const char* nA = has_next ? (const char*)g.A + (size_t)nxt.pm * tstep : cA; const char* nB = has_next ? (const char*)g.Bt + (size_t)nxt.pn * tstep + (size_t)nxt.e * g.bstride : cB;
        for (int t = 0; t < nt; t += 2) {
            const bool last = (t == nt - 2);
            const char* a1 = cA + (size_t)(t + 1) * kstep;
            const char* a2 = last ? nA : cA + (size_t)(t + 2) * kstep; const char* b2 = last ? nB : cB + (size_t)(t + 2) * kstep;
            const char* a3 = a2 + kstep; const char* b3 = b2 + kstep;
            if (last && has_next) S.a_ready(nxt);
            if constexpr (SP2) {
            PG8_LDB(B0, 0, 0); PG8_LDB(B1, 0, 1); PG8_SCHED; PG8_LDA(At, 0, 0); PG8_STAGE(PG8_SA(1, 1), a1 + hstep, voffA);
            PG8_WAIT_V(8); PG8_WAIT_L(0); PG8_BAR; PG8_MMA(0, 0, At, B0); PG8_MMA(0, 1, At, B1); PG8_BAR; PG8_SCHED;
            PG8_LDA(At, 0, 1); PG8_STAGE(PG8_SB(0, 0), b2, voffB); PG8_STAGE(PG8_SB(0, 1), b2 + hstep, voffB); PG8_STAGE(PG8_SA(0, 0), a2, voffA);
            PG8_WAIT_V(8); PG8_WAIT_L(0); PG8_BAR; PG8_MMA(1, 0, At, B0); PG8_MMA(1, 1, At, B1); PG8_BAR; PG8_SCHED;
            PG8_LDB(B0, 1, 0); PG8_LDB(B1, 1, 1); PG8_SCHED; PG8_LDA(At, 1, 0); PG8_STAGE(PG8_SA(0, 1), a2 + hstep, voffA);
            PG8_WAIT_V(8); PG8_WAIT_L(0); PG8_BAR; PG8_MMA(0, 0, At, B0); PG8_MMA(0, 1, At, B1); PG8_BAR; PG8_SCHED;
            PG8_LDA(At, 1, 1); PG8_STAGE(PG8_SB(1, 0), b3, voffB); PG8_STAGE(PG8_SB(1, 1), b3 + hstep, voffB); PG8_STAGE(PG8_SA(1, 0), a3, voffA);
            PG8_WAIT_V(8); PG8_WAIT_L(0); PG8_BAR; PG8_MMA(1, 0, At, B0); PG8_MMA(1, 1, At, B1); PG8_BAR; PG8_SCHED;
            } else {
            PG8_LDB(B0, 0, 0); PG8_SCHED; PG8_LDA(At, 0, 0); PG8_STAGE(PG8_SA(1, 1), a1 + hstep, voffA);
            PG8_WAIT_L(8); PG8_BAR; PG8_WAIT_L(0); PG8_MMA(0, 0, At, B0); PG8_BAR; PG8_SCHED;
            PG8_LDB(B1, 0, 1); PG8_STAGE(PG8_SB(0, 0), b2, voffB);
            PG8_BAR; PG8_WAIT_L(0); PG8_MMA(0, 1, At, B1); PG8_BAR;
            PG8_LDA(At, 0, 1); PG8_STAGE(PG8_SA(0, 0), a2, voffA);
            PG8_BAR; PG8_WAIT_L(0); PG8_MMA(1, 0, At, B0); PG8_BAR; PG8_SCHED;
            PG8_STAGE(PG8_SB(0, 1), b2 + hstep, voffB);
            PG8_WAIT_V(6); PG8_BAR; PG8_MMA(1, 1, At, B1); PG8_BAR;
            PG8_LDB(B0, 1, 0); PG8_SCHED; PG8_LDA(At, 1, 0); PG8_STAGE(PG8_SA(0, 1), a2 + hstep, voffA);
            PG8_WAIT_L(8); PG8_BAR; PG8_WAIT_L(0); PG8_MMA(0, 0, At, B0); PG8_BAR; PG8_SCHED;
            PG8_LDB(B1, 1, 1); PG8_STAGE(PG8_SB(1, 0), b3, voffB);
            PG8_BAR; PG8_WAIT_L(0); PG8_MMA(0, 1, At, B1); PG8_BAR;
            PG8_LDA(At, 1, 1); PG8_STAGE(PG8_SA(1, 0), a3, voffA);
            PG8_BAR; PG8_WAIT_L(0); PG8_MMA(1, 0, At, B0); PG8_BAR; PG8_SCHED;
            PG8_STAGE(PG8_SB(1, 1), b3 + hstep, voffB);
            PG8_WAIT_V(6); PG8_BAR; PG8_MMA(1, 1, At, B1); PG8_BAR;
            }
        }
        if constexpr (ALIGN_EPI) { if (wr == 0) PG8_BAR; }
        if constexpr (!Epi::AFTER_DRAIN) { E(acc, cur, wr, wc, fr, fq); S.done(cur); }
        if (!has_next) break;
#pragma unroll
        for (int a = 0; a < 2; ++a)
#pragma unroll
            for (int b = 0; b < 2; ++b)
#pragma unroll
                for (int m = 0; m < 4; ++m)
#pragma unroll
                    for (int n = 0; n < 2; ++n) acc[a][b][m][n] = (f32x4){0.f, 0.f, 0.f, 0.f};
        cur = nxt; cA = nA; cB = nB; ++ui;
        if constexpr (ALIGN_EPI) { if (wr == 1) PG8_BAR; }
    }
    PG8_WAIT_V(0);
    if constexpr (!ALIGN_EPI) { if (wr == 0) PG8_BAR; }
    PG8_BAR;
    if constexpr (Epi::AFTER_DRAIN) { E.fused(acc, cur, wr, wc, fr, fq, lds, wid, lane); S.done(cur); }
#undef PG8_SA
#undef PG8_SB
#undef PG8_STAGE
#undef PG8_LDA
#undef PG8_LDB
#undef PG8_MMA
#undef PG8_WAIT_V
#undef PG8_WAIT_L
#undef PG8_BAR
#undef PG8_SCHED
}
}

#ifndef PG8_SP2
#define PG8_SP2 true
#endif

namespace pg8 {
DEV float fast_sigmoid(float x) { return __builtin_amdgcn_rcpf(1.f + __builtin_amdgcn_exp2f(-1.4426950409f * x)); }
DEV float fast_silu(float x) { return x * fast_sigmoid(x); }
DEV float fast_gelu_tanh(float x) { return x * __builtin_amdgcn_rcpf(1.f + __builtin_amdgcn_exp2f(-2.3022081984f * (x + 0.044715f * x * x * x))); }
DEV u32x4 pack8(const f32x4 a, const f32x4 b) { u32x4 w; w.x = cvt_pk_bf16(a[0], a[1]); w.y = cvt_pk_bf16(a[2], a[3]); w.z = cvt_pk_bf16(b[0], b[1]); w.w = cvt_pk_bf16(b[2], b[3]); return w; }

struct EpiIn0 {
    static constexpr bool PERM = true, AFTER_DRAIN = false;
    bf16_t* XA; bf16_t* GA; bf16_t* GLU;
    __device__ __forceinline__ void operator()(const f32x4 (&acc)[2][2][4][2], const Unit& u, int wr, int wc, int fr, int fq) const {
        const int row0 = u.pm * BM + wr * 64 + fr;
        if (u.pn < 4) {
            const bool isga = u.pn >= 2;
            if (isga && u.pm >= NTOK / BM) return;
            bf16_t* base = (isga ? GA : XA) + (u.pn & 1) * 256 + wc * 32 + 8 * fq;
#pragma unroll
            for (int ai = 0; ai < 2; ++ai)
#pragma unroll
                for (int m = 0; m < 4; ++m) { bf16_t* rowp = base + (size_t)(row0 + ai * HALF + m * 16) * AW;
#pragma unroll
                    for (int bj = 0; bj < 2; ++bj) { f32x4 v0 = acc[ai][bj][m][0], v1 = acc[ai][bj][m][1];
                        if (isga) {
#pragma unroll
                            for (int j = 0; j < 4; ++j) { v0[j] = fast_gelu_tanh(v0[j]); v1[j] = fast_gelu_tanh(v1[j]); } }
                        *(u32x4*)(rowp + bj * HALF) = pack8(v0, v1); } }
        } else {
            if (u.pm >= NTOK / BM) return;
            bf16_t* base = GLU + (u.pn - 4) * 128 + wc * 32 + 8 * fq;
#pragma unroll
            for (int ai = 0; ai < 2; ++ai)
#pragma unroll
                for (int m = 0; m < 4; ++m) { f32x4 v0, v1;
#pragma unroll
                    for (int j = 0; j < 4; ++j) { v0[j] = acc[ai][0][m][0][j] * fast_sigmoid(acc[ai][1][m][0][j]); v1[j] = acc[ai][0][m][1][j] * fast_sigmoid(acc[ai][1][m][1][j]); }
                    *(u32x4*)(base + (size_t)(row0 + ai * HALF + m * 16) * BWD) = pack8(v0, v1); }
        }
    }
};
struct EpiSwiglu {
    static constexpr bool PERM = true, AFTER_DRAIN = false;
    bf16_t* O; int ldc; int pad;
    __device__ __forceinline__ void operator()(const f32x4 (&acc)[2][2][4][2], const Unit& u, int wr, int wc, int fr, int fq) const {
        const int row0 = u.pm * BM + wr * 64 + fr;
        bf16_t* base = O + u.pn * 128 + wc * 32 + 8 * fq;
#pragma unroll
        for (int ai = 0; ai < 2; ++ai)
#pragma unroll
            for (int m = 0; m < 4; ++m) { f32x4 v0, v1;
#pragma unroll
                for (int j = 0; j < 4; ++j) { v0[j] = fast_silu(acc[ai][0][m][0][j]) * acc[ai][1][m][0][j]; v1[j] = fast_silu(acc[ai][0][m][1][j]) * acc[ai][1][m][1][j]; }
                *(u32x4*)(base + (size_t)(row0 + ai * HALF + m * 16) * ldc) = pack8(v0, v1); }
    }
};
struct EpiIn1 {
    static constexpr bool PERM = true, AFTER_DRAIN = false;
    bf16_t* UVF; size_t stride;
    __device__ __forceinline__ void operator()(const f32x4 (&acc)[2][2][4][2], const Unit& u, int wr, int wc, int fr, int fq) const {
        const int row0 = u.pm * BM + wr * 64 + fr;
        const bool act = u.pn < 4;
        bf16_t* base = UVF + (size_t)(u.pn >> 1) * stride + (u.pn & 1) * 256 + wc * 32 + 8 * fq;
#pragma unroll
        for (int ai = 0; ai < 2; ++ai)
#pragma unroll
            for (int m = 0; m < 4; ++m) { bf16_t* rowp = base + (size_t)(row0 + ai * HALF + m * 16) * CWD;
#pragma unroll
                for (int bj = 0; bj < 2; ++bj) { f32x4 v0 = acc[ai][bj][m][0], v1 = acc[ai][bj][m][1];
                    if (act) {
#pragma unroll
                        for (int j = 0; j < 4; ++j) { v0[j] = fast_gelu_tanh(v0[j]); v1[j] = fast_gelu_tanh(v1[j]); } }
                    *(u32x4*)(rowp + bj * HALF) = pack8(v0, v1); } }
    }
};
struct EpiDft {
    static constexpr bool PERM = true, AFTER_DRAIN = false;
    bf16_t* A3;
    __device__ __forceinline__ void operator()(const f32x4 (&acc)[2][2][4][2], const Unit& u, int wr, int wc, int fr, int fq) const {
        const int row0 = u.pm * BM + wr * 64 + fr;
#pragma unroll
        for (int bj = 0; bj < 2; ++bj) { const int bg = u.pn * 2 + bj, b = bg >> 2, g = bg & 3;
            bf16_t* base = A3 + (size_t)b * SEQ * DM + CWD + g * DGD + wc * 32 + 8 * fq;
#pragma unroll
            for (int ai = 0; ai < 2; ++ai)
#pragma unroll
                for (int m = 0; m < 4; ++m) { const f32x4 v0 = acc[ai][bj][m][0] * (1.f / 512.f), v1 = acc[ai][bj][m][1] * (1.f / 512.f);
                    *(u32x4*)(base + (size_t)(row0 + ai * HALF + m * 16) * DM) = pack8(v0, v1); } }
    }
};
}

constexpr size_t MiB = 1u << 20;
constexpr size_t WS_CTL = 0, CTL_ZERO_BYTES = 1 * MiB;
constexpr size_t WS_ADA = 1 * MiB;
constexpr size_t WS_PE = WS_ADA + 512 * 1024;
constexpr size_t WS_ROUTE = 2 * MiB;
constexpr size_t WS_MW13 = 4 * MiB, WS_MW2 = 116 * MiB;
constexpr size_t WS_HG = 172 * MiB;
constexpr size_t WS_ACTM = 240 * MiB;
constexpr size_t WS_WIN0 = 172 * MiB, WS_WOUT0 = 176 * MiB, WS_W13 = 178 * MiB, WS_W2 = 189 * MiB, WS_CDIN = 195 * MiB, WS_CDOUT = 198 * MiB, WS_DFTA = 200 * MiB;
constexpr size_t WS_Y = 216 * MiB;
constexpr size_t WS_R2 = 248 * MiB;
constexpr size_t WS_XARAW = WS_R2, WS_GA = WS_R2 + 18 * MiB, WS_GLU = WS_R2 + 34 * MiB, WS_A2 = WS_R2 + 50 * MiB;
constexpr size_t WS_HL = WS_R2 + 82 * MiB, WS_PF = WS_R2 + 98 * MiB, WS_PB = WS_R2 + 114 * MiB, WS_AGG = WS_R2 + 130 * MiB;
constexpr size_t WS_NXA = WS_R2 + 133 * MiB, WS_NHSUM = WS_R2 + 169 * MiB;
constexpr size_t WS_ACT = WS_R2;
constexpr size_t WS_U = WS_R2, WS_V = WS_R2 + 16 * MiB, WS_F = WS_R2 + 32 * MiB, WS_ZT = WS_R2 + 82 * MiB, WS_NVLN = WS_R2 + 114 * MiB;
constexpr size_t WS_NOUTMOE = 216 * MiB, WS_NACTE = 280 * MiB;
constexpr size_t WS_H = 476 * MiB, WS_END = 512 * MiB;
constexpr int CW_BAR = 4096;

constexpr int LDS_BYTES = 147456;
constexpr int RING_BYTES = 131072, LDSCTL_OFF = RING_BYTES, MISC_OFF = LDSCTL_OFF + 320;

#define GAS __attribute__((address_space(1)))
#define LAS __attribute__((address_space(3)))
typedef unsigned v4u __attribute__((ext_vector_type(4)));
typedef unsigned v2u __attribute__((ext_vector_type(2)));
typedef float f32x4 __attribute__((ext_vector_type(4)));
typedef short bf16x8 __attribute__((ext_vector_type(8)));
#define LDS_WAIT() asm volatile("s_waitcnt lgkmcnt(0)" ::: "memory")
#define VM_WAIT() asm volatile("s_waitcnt vmcnt(0)" ::: "memory")
DEV unsigned pk2(float lo, float hi) { return (unsigned)f2bf(lo) | ((unsigned)f2bf(hi) << 16); }

#define XB_TMO      128
#define XB_XCNT(j)  (256  + 64 * (j))
#define XB_XSUB(j)  (1280 + 64 * (j))
#define XB_XGEN(j)  (2304 + 64 * (j))
#define XB_TOP      3328
#define XB_TOPGEN   3392
#define XCD_BAR_WORDS 3456
#define XB_SPIN_CAP (1u << 18)
__device__ __forceinline__ unsigned xb_ld(unsigned* p)              { return __hip_atomic_load(p, __ATOMIC_RELAXED, __HIP_MEMORY_SCOPE_AGENT); }
__device__ __forceinline__ unsigned xb_add(unsigned* p, unsigned v) { return __hip_atomic_fetch_add(p, v, __ATOMIC_RELAXED, __HIP_MEMORY_SCOPE_AGENT); }
__device__ __forceinline__ unsigned xb_xcc_id() { return (unsigned)__builtin_amdgcn_s_getreg((3 << 11) | 20) & 0xFu; }
#define XB_SPIN(cond, bar) do { unsigned _sp = 0; while (cond) { __builtin_amdgcn_s_sleep(1); \
    if ((++_sp & 255u) == 0u) { if (xb_ld(&(bar)[XB_TMO])) break; if (_sp > XB_SPIN_CAP) { atomicAdd(&(bar)[XB_TMO], 1u); break; } } } } while (0)
struct XcdBarrier { unsigned* bar; unsigned x; volatile LAS unsigned* st; };
__device__ __forceinline__ XcdBarrier xcd_barrier_post(unsigned* bar, volatile LAS unsigned* st) {
    XcdBarrier b; b.bar = bar; b.x = xb_xcc_id(); b.st = st;
    if (threadIdx.x == 0) (void)xb_add(&bar[XB_XCNT(b.x)], 1u);
    return b;
}
__device__ __forceinline__ void xcd_barrier_complete(unsigned* bar, unsigned x, unsigned& nloc, unsigned& nx) {
    const unsigned G = gridDim.x * gridDim.y * gridDim.z;
    unsigned sum, cnt, mine, sp = 0u;
    for (;;) {
        sum = 0u; cnt = 0u; mine = 0u;
#pragma unroll
        for (unsigned j = 0; j < 16; ++j) { const unsigned c = xb_ld(&bar[XB_XCNT(j)]); sum += c; cnt += (c > 0u) ? 1u : 0u; mine = (j == x) ? c : mine; }
        if (sum == G) break;
        __builtin_amdgcn_s_sleep(1);
        if ((++sp & 255u) == 0u) { if (xb_ld(&bar[XB_TMO])) break; if (sp > XB_SPIN_CAP) { atomicAdd(&bar[XB_TMO], 1u); break; } }
    }
    nloc = mine > 0u ? mine : 1u; nx = cnt > 0u ? cnt : 1u;
}
__device__ __forceinline__ void xcd_barrier(const XcdBarrier& b) {
    asm volatile("s_waitcnt vmcnt(0)" ::: "memory");
    __syncthreads();
    if (threadIdx.x == 0) {
        unsigned* bar = b.bar;
        __builtin_amdgcn_s_waitcnt(0);
        unsigned nloc = b.st[0], nx = b.st[1];
        if (nloc == 0u) { xcd_barrier_complete(bar, b.x, nloc, nx); b.st[0] = nloc; b.st[1] = nx; }
        const unsigned old = xb_add(&bar[XB_XSUB(b.x)], 1u);
        const unsigned gen = old / nloc;
        if (old + 1u == (gen + 1u) * nloc) {
            __builtin_amdgcn_fence(__ATOMIC_RELEASE, "agent");
            asm volatile("s_waitcnt vmcnt(0)" ::: "memory");
            const unsigned og = xb_add(&bar[XB_TOP], 1u);
            const unsigned tg = og / nx;
            if (og + 1u == (tg + 1u) * nx) xb_add(&bar[XB_TOPGEN], 1u);
            else XB_SPIN(xb_ld(&bar[XB_TOPGEN]) == tg, bar);
            __builtin_amdgcn_fence(__ATOMIC_ACQUIRE, "agent");
            xb_add(&bar[XB_XGEN(b.x)], 1u);
            asm volatile("s_waitcnt vmcnt(0)" ::: "memory");
        } else {
            XB_SPIN(xb_ld(&bar[XB_XGEN(b.x)]) == gen, bar);
            __builtin_amdgcn_fence(__ATOMIC_ACQUIRE, "agent");
            asm volatile("s_waitcnt vmcnt(0)" ::: "memory");
        }
    }
    __syncthreads();
}

struct Args { const float* in[33]; float* out; unsigned char* ws; int ph_lo, ph_hi; };
struct Frame {
    LAS unsigned char* lds;
    volatile LAS unsigned* MISC;
    unsigned* ctl;
    int tid, lane, wave, vcu, G;
    const float* const* in;
    float* X; unsigned char* ws;
};
#define WSP(T, off) ((T*)(F.ws + (off)))

struct WtJob { const float* W; bf16* WT; int ldw, col0, ncols, K, row_off, mode, half; };
DEV void wt_item(const WtJob& j, int item, LAS float* scr, int lane) {
    const int nblk = j.ncols / 32, kb = item / nblk, nb = item % nblk, k0 = 64 * kb, n0 = 32 * nb;
    const float* W = j.W + (size_t)k0 * j.ldw + j.col0 + n0 + (lane & 31);
#pragma unroll 8
    for (int i = 0; i < 32; ++i) { const int kk = 2 * i + (lane >> 5); scr[kk * 33 + (lane & 31)] = W[(size_t)kk * j.ldw]; }
    LDS_WAIT(); asm volatile("" ::: "memory");
    const int c = lane & 7;
    const int nm0 = j.mode ? (n0 / 128) * 256 + j.half * 128 + (n0 % 128) : n0;
#pragma unroll
    for (int q = 0; q < 4; ++q) { const int n = (lane >> 3) + 8 * q; const LAS float* s = scr + (8 * c) * 33 + n;
        v4u o; o.x = pk2(s[0 * 33], s[1 * 33]); o.y = pk2(s[2 * 33], s[3 * 33]); o.z = pk2(s[4 * 33], s[5 * 33]); o.w = pk2(s[6 * 33], s[7 * 33]);
        *(GAS v4u*)(j.WT + (size_t)(j.row_off + nm0 + n) * j.K + k0 + 8 * c) = o; }
    LDS_WAIT(); asm volatile("" ::: "memory");
}
constexpr int WT_BASE_ITEMS = 512 + 256 + 256 + 512 + 1408 * 3 + 768 + 512;
constexpr int WT_MOE_ITEMS = 1792;
constexpr int WT_ITEMS = WT_BASE_ITEMS + NE * 3 * WT_MOE_ITEMS;
#define WT_SET(W_, WT_, ldw_, col0_, ncols_, K_, row_off_, mode_, half_) do { j.W = (W_); j.WT = (WT_); j.ldw = (ldw_); j.col0 = (col0_); j.ncols = (ncols_); j.K = (K_); j.row_off = (row_off_); j.mode = (mode_); j.half = (half_); } while (0)
DEV bool wt_job(const Frame& F, int it, WtJob& j, int& item) {
    int r = it;
    if (r < 512) { WT_SET(F.in[7], WSP(bf16, WS_WIN0), 2048, 0, 1024, DM, 0, 0, 0); item = r; return true; } r -= 512;
    if (r < 256) { WT_SET(F.in[7], WSP(bf16, WS_WIN0), 2048, 1024, 512, DM, 1024, 1, 0); item = r; return true; } r -= 256;
    if (r < 256) { WT_SET(F.in[7], WSP(bf16, WS_WIN0), 2048, 1536, 512, DM, 1024, 1, 1); item = r; return true; } r -= 256;
    if (r < 512) { WT_SET(F.in[19], WSP(bf16, WS_WOUT0), DM, 0, DM, DM, 0, 0, 0); item = r; return true; } r -= 512;
    if (r < 1408) { WT_SET(F.in[20], WSP(bf16, WS_W13), DFF, 0, DFF, DM, 0, 1, 0); item = r; return true; } r -= 1408;
    if (r < 1408) { WT_SET(F.in[21], WSP(bf16, WS_W13), DFF, 0, DFF, DM, 0, 1, 1); item = r; return true; } r -= 1408;
    if (r < 1408) { WT_SET(F.in[22], WSP(bf16, WS_W2), DM, 0, DM, DFF, 0, 0, 0); item = r; return true; } r -= 1408;
    if (r < 768) { WT_SET(F.in[23], WSP(bf16, WS_CDIN), 1536, 0, 1536, DM, 0, 0, 0); item = r; return true; } r -= 768;
    if (r < 512) { WT_SET(F.in[28], WSP(bf16, WS_CDOUT), DM, 0, DM, DM, 0, 0, 0); item = r; return true; } r -= 512;
    const int mi = r / WT_MOE_ITEMS, e = mi / 3, kind = mi % 3; item = r % WT_MOE_ITEMS;
    if (e >= NE) return false;
    if (kind == 0) WT_SET(F.in[30] + (size_t)e * DM * DFE, WSP(bf16, WS_MW13) + (size_t)e * 2 * DFE * DM, DFE, 0, DFE, DM, 0, 1, 0);
    else if (kind == 1) WT_SET(F.in[31] + (size_t)e * DM * DFE, WSP(bf16, WS_MW13) + (size_t)e * 2 * DFE * DM, DFE, 0, DFE, DM, 0, 1, 1);
    else WT_SET(F.in[32] + (size_t)e * DFE * DM, WSP(bf16, WS_MW2) + (size_t)e * DM * DFE, DM, 0, DM, DFE, 0, 0, 0);
    return true;
}
DEV float wave_sum_all(float v) {
#pragma unroll
    for (int o = 1; o < 64; o <<= 1) v += __shfl_xor(v, o);
    return v;
}

DEV void p0_prologue(Frame& F) {
    const int tid = F.tid, lane = F.lane, wave = F.wave, bx = blockIdx.x;
    if (bx < 192) {
        LAS float* st = (LAS float*)(F.lds);
        LAS float* part = (LAS float*)(F.lds + 40960);
        const float* c = F.in[1]; const float* cctx = F.in[3];
        for (int i = tid; i < 9 * DM; i += 512) { const int r = i / DM, k = i % DM; const float v = r < 8 ? c[r * DM + k] : cctx[k]; st[i] = v / (1.f + expf(-v)); }
        __syncthreads();
        const int l = bx / 96, cs = (bx % 96) * 64;
        const float* w = F.in[4] + (size_t)l * DM * 6 * DM + cs + lane;
        float acc[9];
#pragma unroll
        for (int r = 0; r < 9; ++r) acc[r] = 0.f;
#pragma unroll 8
        for (int k = wave * 128; k < wave * 128 + 128; ++k) { const float wv = w[(size_t)k * 6 * DM];
#pragma unroll
            for (int r = 0; r < 9; ++r) acc[r] += st[r * DM + k] * wv; }
#pragma unroll
        for (int r = 0; r < 9; ++r) part[(wave * 9 + r) * 64 + lane] = acc[r];
        __syncthreads();
        float* ADA = WSP(float, WS_ADA);
        for (int i = tid; i < 9 * 64; i += 512) { const int r = i / 64, cl = i % 64; float s = F.in[5][l * 6 * DM + cs + cl];
#pragma unroll
            for (int w8 = 0; w8 < 8; ++w8) s += part[(w8 * 9 + r) * 64 + cl];
            ADA[(size_t)(l * 9 + r) * 6 * DM + cs + cl] = s; }
        __syncthreads();
    }
    { const int idx = bx * 512 + tid;
      if (idx < 96 * 512) { const int p = idx / 512, j = idx % 512, f = j % 256; const float pos = (float)(p < 32 ? p : p - 32);
          const float ang = pos * powf(10000.f, -(float)f / 256.f); WSP(float, WS_PE)[idx] = (j < 256) ? sinf(ang) : cosf(ang); } }
    { LAS float* T = (LAS float*)(F.lds);
      for (int i = tid; i < SEQ; i += 512) T[i] = cospif((float)i * (2.f / SEQ));
      __syncthreads();
      bf16* DFTA = WSP(bf16, WS_DFTA);
      for (int ch = tid; ch < 8 * 512; ch += 512) { const int k1 = 8 * bx + ch / 512, j0 = (ch % 512) * 8; const bool isc = j0 < SEQ; const int l0 = isc ? j0 : j0 - SEQ;
          float v[8];
#pragma unroll
          for (int q = 0; q < 8; ++q) { const int m = (k1 * (l0 + q)) & (SEQ - 1); v[q] = isc ? T[m] : -T[(m - SEQ / 4) & (SEQ - 1)]; }
          v4u o; o.x = pk2(v[0], v[1]); o.y = pk2(v[2], v[3]); o.z = pk2(v[4], v[5]); o.w = pk2(v[6], v[7]);
          *(GAS v4u*)(DFTA + (size_t)k1 * 2 * SEQ + j0) = o; }
      __syncthreads(); }
    { LAS float* scr = (LAS float*)(F.lds + wave * 16384);
      const int gw = F.vcu * 8 + wave, NGW = F.G * 8;
      for (int it = gw; it < WT_ITEMS; it += NGW) { WtJob j; int item; if (wt_job(F, it, j, item)) wt_item(j, item, scr, lane); } }
}

DEV void p1_rows(Frame& F) {
    const int lane = F.lane, gw = F.vcu * 8 + F.wave, NGW = F.G * 8;
    const float* ADA0 = WSP(float, WS_ADA); const float* PE = WSP(float, WS_PE); const float* gain = F.in[6];
    bf16* H = WSP(bf16, WS_H);
    for (int row = gw; row < NROWS; row += NGW) {
        const bool lat = row < NTOK;
        const f32x4* src = (const f32x4*)(lat ? F.in[0] + (size_t)row * DM : F.in[2] + (size_t)(row - NTOK) * DM);
        const int arow = lat ? row / SEQ : 8;
        f32x4 v[4];
#pragma unroll
        for (int j = 0; j < 4; ++j) v[j] = src[lane + 64 * j];
        if (lat) { const int t = row % SEQ; const f32x4* pr = (const f32x4*)(PE + (size_t)(t / GRIDW) * 512); const f32x4* pc = (const f32x4*)(PE + (size_t)(32 + t % GRIDW) * 512);
            v[0] += pr[lane]; v[1] += pr[lane + 64]; v[2] += pc[lane]; v[3] += pc[lane + 64];
            f32x4* xo = (f32x4*)(F.X + (size_t)row * DM);
#pragma unroll
            for (int j = 0; j < 4; ++j) xo[lane + 64 * j] = v[j]; }
        float ss = 0.f;
#pragma unroll
        for (int j = 0; j < 4; ++j) ss += (v[j][0] * v[j][0] + v[j][1] * v[j][1]) + (v[j][2] * v[j][2] + v[j][3] * v[j][3]);
        const float r = rsqrtf(wave_sum_all(ss) * (1.f / DM) + NORM_EPS);
        const f32x4* sh = (const f32x4*)(ADA0 + (size_t)arow * 6 * DM); const f32x4* sc = (const f32x4*)(ADA0 + (size_t)arow * 6 * DM + DM); const f32x4* g4 = (const f32x4*)gain;
        v2u* ho = (v2u*)(H + (size_t)row * DM);
#pragma unroll
        for (int j = 0; j < 4; ++j) { const f32x4 h = (v[j] * r * g4[lane + 64 * j]) * (1.f + sc[lane + 64 * j]) + sh[lane + 64 * j];
            v2u o; o.x = pk2(h[0], h[1]); o.y = pk2(h[2], h[3]); ho[lane + 64 * j] = o; }
    }
}
DEV void thin_rows(Frame& F, const bf16* Y, const float* gpost, const float* ADAres, int g_off, const float* gpre, const float* ADAnxt, int sh_off, int sc_off) {
    const int lane = F.lane, gw = F.vcu * 8 + F.wave, NGW = F.G * 8;
    bf16* H = WSP(bf16, WS_H);
    for (int row = gw; row < NTOK; row += NGW) {
        const int b = row / SEQ;
        const v2u* yp = (const v2u*)(Y + (size_t)row * DM);
        f32x4 y[4]; float ss = 0.f;
#pragma unroll
        for (int j = 0; j < 4; ++j) { const v2u w = yp[lane + 64 * j]; y[j][0] = __uint_as_float(w.x << 16); y[j][1] = __uint_as_float(w.x & 0xffff0000u); y[j][2] = __uint_as_float(w.y << 16); y[j][3] = __uint_as_float(w.y & 0xffff0000u);
            ss += (y[j][0] * y[j][0] + y[j][1] * y[j][1]) + (y[j][2] * y[j][2] + y[j][3] * y[j][3]); }
        const float ry = rsqrtf(wave_sum_all(ss) * (1.f / DM) + NORM_EPS);
        f32x4* xp = (f32x4*)(F.X + (size_t)row * DM);
        const f32x4* gt = (const f32x4*)(ADAres + (size_t)b * 6 * DM + g_off); const f32x4* gp = (const f32x4*)gpost;
        f32x4 x[4]; float sx = 0.f;
#pragma unroll
        for (int j = 0; j < 4; ++j) { x[j] = xp[lane + 64 * j] + gt[lane + 64 * j] * (y[j] * ry * gp[lane + 64 * j]); xp[lane + 64 * j] = x[j];
            sx += (x[j][0] * x[j][0] + x[j][1] * x[j][1]) + (x[j][2] * x[j][2] + x[j][3] * x[j][3]); }
        const float rx = rsqrtf(wave_sum_all(sx) * (1.f / DM) + NORM_EPS);
        const f32x4* sh = (const f32x4*)(ADAnxt + (size_t)b * 6 * DM + sh_off); const f32x4* sc = (const f32x4*)(ADAnxt + (size_t)b * 6 * DM + sc_off); const f32x4* g4 = (const f32x4*)gpre;
        v2u* ho = (v2u*)(H + (size_t)row * DM);
#pragma unroll
        for (int j = 0; j < 4; ++j) { const f32x4 h = (x[j] * rx * g4[lane + 64 * j]) * (1.f + sc[lane + 64 * j]) + sh[lane + 64 * j];
            v2u o; o.x = pk2(h[0], h[1]); o.y = pk2(h[2], h[3]); ho[lane + 64 * j] = o; }
    }
}


constexpr int P3_WB = 0, P3_CONST = 36864, P3_XAB = 40960, P3_XAF = 50176, P3_SUB = 66816, P3_OUTS = 83200;
constexpr int P3_ROWB = 144;
constexpr int P3_XAF_LD = 65;
constexpr int P3_OUT_LD = 72;
constexpr int P3B_IN = 0, P3B_OUT = 63488;
constexpr int NSLOT = 36;
DEV size_t agg_idx(int b, int slot, int dir, int k) { return ((size_t)(((b * NSLOT + slot) * 2 + dir) * 2 + k)) * AW; }
DEV void unpack8f(const v4u v, float* f) {
    f[0] = __uint_as_float(v.x << 16); f[1] = __uint_as_float(v.x & 0xffff0000u); f[2] = __uint_as_float(v.y << 16); f[3] = __uint_as_float(v.y & 0xffff0000u);
    f[4] = __uint_as_float(v.z << 16); f[5] = __uint_as_float(v.z & 0xffff0000u); f[6] = __uint_as_float(v.w << 16); f[7] = __uint_as_float(v.w & 0xffff0000u);
}
DEV float fsig(float x) { return __builtin_amdgcn_rcpf(1.f + __builtin_amdgcn_exp2f(-1.4426950409f * x)); }

DEV void mix0_local(Frame& F) {
    const int tid = F.tid, lane = F.lane, wave = F.wave, bx = blockIdx.x;
    {
        const float* dw_w = F.in[15]; const float* dw_b = F.in[16]; const float* ln_g = F.in[17]; const float* ln_b = F.in[18];
        const bf16* GLU = WSP(bf16, WS_GLU); bf16* A2 = WSP(bf16, WS_A2);
        const int cp = tid & 255, th = tid >> 8;
        float w0[CONVB], w1[CONVB];
#pragma unroll
        for (int j = 0; j < CONVB; ++j) { w0[j] = dw_w[j * BWD + 2 * cp]; w1[j] = dw_w[j * BWD + 2 * cp + 1]; }
        const float bias0 = dw_b[2 * cp], bias1 = dw_b[2 * cp + 1];
        for (int i = 0; i < 2; ++i) {
            const int tb = bx + 256 * i, b = tb >> 6, tseq0 = (tb & 63) * 32;
            for (int c = tid; c < 62 * 64; c += 512) { const int lr = c >> 6, cc = c & 63, ts = tseq0 - 15 + lr;
                v4u v = {0u, 0u, 0u, 0u};
                if (ts >= 0 && ts < SEQ) v = *(const GAS v4u*)(GLU + (size_t)(b * SEQ + ts) * BWD + cc * 8);
                *(LAS v4u*)(F.lds + P3B_IN + lr * 1024 + cc * 16) = v; }
            __syncthreads();
            float acc0[16], acc1[16];
#pragma unroll
            for (int t = 0; t < 16; ++t) { acc0[t] = bias0; acc1[t] = bias1; }
#pragma unroll
            for (int rr = 0; rr < 46; ++rr) {
                const unsigned w = *(const LAS unsigned*)(F.lds + P3B_IN + (16 * th + rr) * 1024 + cp * 4);
                const float x0 = __uint_as_float(w << 16), x1 = __uint_as_float(w & 0xffff0000u);
#pragma unroll
                for (int t = 0; t < 16; ++t) { const int j = rr - t; if (j >= 0 && j < CONVB) { acc0[t] += w0[j] * x0; acc1[t] += w1[j] * x1; } }
            }
#pragma unroll
            for (int t = 0; t < 16; ++t) { typedef float f32x2 __attribute__((ext_vector_type(2))); *(LAS f32x2*)(F.lds + P3B_OUT + ((16 * th + t) * 512 + 2 * cp) * 4) = (f32x2){acc0[t], acc1[t]}; }
            __syncthreads();
#pragma unroll
            for (int q = 0; q < 4; ++q) { const int tl = 4 * wave + q; const LAS f32x4* row = (const LAS f32x4*)(F.lds + P3B_OUT + tl * 2048);
                const f32x4 v0 = row[lane], v1 = row[lane + 64];
                const float mu = wave_sum_all((v0[0] + v0[1]) + (v0[2] + v0[3]) + (v1[0] + v1[1]) + (v1[2] + v1[3])) * (1.f / BWD);
                const f32x4 d0 = v0 - mu, d1 = v1 - mu;
                const float var = wave_sum_all((d0[0] * d0[0] + d0[1] * d0[1]) + (d0[2] * d0[2] + d0[3] * d0[3]) + (d1[0] * d1[0] + d1[1] * d1[1]) + (d1[2] * d1[2] + d1[3] * d1[3])) * (1.f / BWD);
                const float rs = rsqrtf(var + LN_EPS);
                const f32x4 g0 = ((const f32x4*)ln_g)[lane], g1 = ((const f32x4*)ln_g)[lane + 64], b0 = ((const f32x4*)ln_b)[lane], b1 = ((const f32x4*)ln_b)[lane + 64];
                f32x4 y0 = d0 * rs * g0 + b0, y1 = d1 * rs * g1 + b1;
#pragma unroll
                for (int k = 0; k < 4; ++k) { y0[k] = y0[k] * fsig(y0[k]); y1[k] = y1[k] * fsig(y1[k]); }
                bf16* orow = A2 + (size_t)(b * SEQ + tseq0 + tl) * DM + BWD;
                v2u o0, o1; o0.x = pk2(y0[0], y0[1]); o0.y = pk2(y0[2], y0[3]); o1.x = pk2(y1[0], y1[1]); o1.y = pk2(y1[2], y1[3]);
                ((v2u*)orow)[lane] = o0; ((v2u*)orow)[lane + 64] = o1; }
            __syncthreads();
        }
    }
    const int h = bx & 7;
    {
        for (int idx = tid; idx < 4 * 4096; idx += 512) { const int g = idx >> 12, d = (idx >> 6) & 63, e = idx & 63, dir = g >> 1;
            const float* src = ((g & 1) ? F.in[12] : F.in[10]) + (size_t)((dir * AHEADS + h) * AHD) * AHD;
            *(LAS bf16*)(F.lds + P3_WB + g * 9216 + e * P3_ROWB + d * 2) = f2bf(src[d * AHD + e]); }
        LAS float* cst = (LAS float*)(F.lds + P3_CONST);
        if (tid < 128) { const int dir = tid >> 6, e = tid & 63, ch = dir * AW + h * AHD + e;
            cst[(dir * 3 + 0) * 64 + e] = F.in[11][ch]; cst[(dir * 3 + 1) * 64 + e] = F.in[13][ch];
            const float nl = -F.in[14][ch]; cst[(dir * 3 + 2) * 64 + e] = nl > 20.f ? nl : log1pf(expf(nl)); }
        if (tid >= 128 && tid < 128 + 256) { const int q = tid - 128, j = q >> 6, e = q & 63; cst[384 + q] = F.in[8][j * AW + h * AHD + e]; }
        if (tid >= 384 && tid < 448) { const int e = tid - 384; cst[640 + e] = F.in[9][h * AHD + e]; }
        __syncthreads();
    }
    const bf16* XA_RAW = WSP(bf16, WS_XARAW);
    bf16* HLp = WSP(bf16, WS_HL); bf16* PFp = WSP(bf16, WS_PF); bf16* PBp = WSP(bf16, WS_PB); float* AGG = WSP(float, WS_AGG);
    const LAS float* cst = (const LAS float*)(F.lds + P3_CONST);
    LAS float* XAF = (LAS float*)(F.lds + P3_XAF);
    LAS float* SUB = (LAS float*)(F.lds + P3_SUB);
    const int mt = wave >> 1, nt0 = (wave & 1) * 2, fr = lane & 15, fq = lane >> 4, sidx = mt * 4 + fq;
    for (int i = 0; i < 9; ++i) {
        const int u = bx + 256 * i, cidx = u >> 3;
        const bool isctx = cidx >= 256;
        int b, cc, seg0, seglen, slot;
        if (!isctx) { b = cidx >> 5; cc = cidx & 31; seg0 = b * SEQ; seglen = SEQ; slot = 4 + cc; }
        else { const int k = cidx - 256; b = k >> 2; cc = k & 3; seg0 = NTOK + b * CTXL; seglen = CTXL; slot = cc; }
        const int t0 = cc * 64;
        { const int t = tid >> 3, c8 = tid & 7;
          float acc[8];
#pragma unroll
          for (int q = 0; q < 8; ++q) acc[q] = cst[640 + c8 * 8 + q];
#pragma unroll
          for (int j = 0; j < 4; ++j) { const int tt = t0 + t + j - 1;
              if (tt >= 0 && tt < seglen) { float xv[8]; unpack8f(*(const GAS v4u*)(XA_RAW + (size_t)(seg0 + tt) * AW + h * AHD + c8 * 8), xv);
#pragma unroll
                  for (int q = 0; q < 8; ++q) acc[q] += cst[384 + j * 64 + c8 * 8 + q] * xv[q]; } }
#pragma unroll
          for (int q = 0; q < 8; ++q) XAF[t * P3_XAF_LD + c8 * 8 + q] = acc[q];
          v4u o; o.x = pk2(acc[0], acc[1]); o.y = pk2(acc[2], acc[3]); o.z = pk2(acc[4], acc[5]); o.w = pk2(acc[6], acc[7]);
          *(LAS v4u*)(F.lds + P3_XAB + t * P3_ROWB + c8 * 16) = o; }
        __syncthreads();
        float hlf[2][4], pf[2][4], hlb[2][4], pb[2][4];
        { bf16x8 afr[2];
#pragma unroll
          for (int ks = 0; ks < 2; ++ks) afr[ks] = *(const LAS bf16x8*)(F.lds + P3_XAB + (mt * 16 + fr) * P3_ROWB + (ks * 32 + fq * 8) * 2);
#pragma unroll
          for (int ntl = 0; ntl < 2; ++ntl) { const int nt = nt0 + ntl, ch = nt * 16 + fr;
              f32x4 acc[4];
#pragma unroll
              for (int g = 0; g < 4; ++g) { acc[g] = (f32x4){0.f, 0.f, 0.f, 0.f};
#pragma unroll
                  for (int ks = 0; ks < 2; ++ks) { const bf16x8 bfr = *(const LAS bf16x8*)(F.lds + P3_WB + g * 9216 + (nt * 16 + fr) * P3_ROWB + (ks * 32 + fq * 8) * 2);
                      acc[g] = __builtin_amdgcn_mfma_f32_16x16x32_bf16(afr[ks], bfr, acc[g], 0, 0, 0); } }
              float xa[4];
#pragma unroll
              for (int q = 0; q < 4; ++q) xa[q] = XAF[(mt * 16 + 4 * fq + q) * P3_XAF_LD + ch];
#pragma unroll
              for (int dir = 0; dir < 2; ++dir) { const float br = cst[(dir * 3 + 0) * 64 + ch], bi = cst[(dir * 3 + 1) * 64 + ch], sp = cst[(dir * 3 + 2) * 64 + ch];
                  float av[4], bv[4];
#pragma unroll
                  for (int q = 0; q < 4; ++q) { const float r = fsig(acc[2 * dir][q] + br), ig = fsig(acc[2 * dir + 1][q] + bi);
                      const float la = -8.f * r * sp; const float a = __builtin_amdgcn_exp2f(1.4426950409f * la);
                      av[q] = a; bv[q] = sqrtf(fmaxf(1.f - a * a, 0.f)) * (ig * xa[q]); }
                  if (dir == 0) { float hh = 0.f, pp = 1.f;
#pragma unroll
                      for (int q = 0; q < 4; ++q) { hh = av[q] * hh + bv[q]; pp *= av[q]; hlf[ntl][q] = hh; pf[ntl][q] = pp; }
                      typedef float f32x2 __attribute__((ext_vector_type(2))); *(LAS f32x2*)(SUB + ((0 * 16 + sidx) * 64 + ch) * 2) = (f32x2){pp, hh}; }
                  else { float hh = 0.f, pp = 1.f;
#pragma unroll
                      for (int q = 3; q >= 0; --q) { hh = av[q] * hh + bv[q]; pp *= av[q]; hlb[ntl][q] = hh; pb[ntl][q] = pp; }
                      typedef float f32x2 __attribute__((ext_vector_type(2))); *(LAS f32x2*)(SUB + ((1 * 16 + sidx) * 64 + ch) * 2) = (f32x2){pp, hh}; } } } }
        __syncthreads();
#pragma unroll
        for (int ntl = 0; ntl < 2; ++ntl) { const int ch = (nt0 + ntl) * 16 + fr;
            typedef float f32x2 __attribute__((ext_vector_type(2)));
            float cf = 0.f, apf = 1.f;
            for (int s = 0; s < sidx; ++s) { const f32x2 ab = *(const LAS f32x2*)(SUB + ((0 * 16 + s) * 64 + ch) * 2); cf = ab.x * cf + ab.y; apf *= ab.x; }
            float cb = 0.f, apb = 1.f;
            for (int s = 15; s > sidx; --s) { const f32x2 ab = *(const LAS f32x2*)(SUB + ((1 * 16 + s) * 64 + ch) * 2); cb = ab.x * cb + ab.y; apb *= ab.x; }
            if (sidx == 15) { const f32x2 ab = *(const LAS f32x2*)(SUB + ((0 * 16 + 15) * 64 + ch) * 2);
                AGG[agg_idx(b, slot, 0, 0) + h * AHD + ch] = apf * ab.x; AGG[agg_idx(b, slot, 0, 1) + h * AHD + ch] = ab.x * cf + ab.y; }
            if (sidx == 0) { const f32x2 ab = *(const LAS f32x2*)(SUB + ((1 * 16 + 0) * 64 + ch) * 2);
                AGG[agg_idx(b, slot, 1, 0) + h * AHD + ch] = apb * ab.x; AGG[agg_idx(b, slot, 1, 1) + h * AHD + ch] = ab.x * cb + ab.y; }
            if (!isctx) {
#pragma unroll
                for (int q = 0; q < 4; ++q) { const int t = mt * 16 + 4 * fq + q;
                    const float hl = (hlf[ntl][q] + pf[ntl][q] * cf) + (hlb[ntl][q] + pb[ntl][q] * cb);
                    *(LAS bf16*)(F.lds + P3_OUTS + (0 * 64 + t) * (P3_OUT_LD * 2) + ch * 2) = f2bf(hl);
                    *(LAS bf16*)(F.lds + P3_OUTS + (1 * 64 + t) * (P3_OUT_LD * 2) + ch * 2) = f2bf(pf[ntl][q] * apf);
                    *(LAS bf16*)(F.lds + P3_OUTS + (2 * 64 + t) * (P3_OUT_LD * 2) + ch * 2) = f2bf(pb[ntl][q] * apb); } } }
        __syncthreads();
        if (!isctx) { const int t = tid >> 3, c8 = tid & 7; const size_t go = (size_t)(seg0 + t0 + t) * AW + h * AHD + c8 * 8;
            *(GAS v4u*)(HLp + go) = *(const LAS v4u*)(F.lds + P3_OUTS + (0 * 64 + t) * (P3_OUT_LD * 2) + c8 * 16);
            *(GAS v4u*)(PFp + go) = *(const LAS v4u*)(F.lds + P3_OUTS + (1 * 64 + t) * (P3_OUT_LD * 2) + c8 * 16);
            *(GAS v4u*)(PBp + go) = *(const LAS v4u*)(F.lds + P3_OUTS + (2 * 64 + t) * (P3_OUT_LD * 2) + c8 * 16); }
    }
    __syncthreads();
}

DEV void mix0_carry(Frame& F) {
    const int tid = F.tid, wave = F.wave, lane = F.lane;
    const float* AGG = WSP(float, WS_AGG);
    const bf16* HLp = WSP(bf16, WS_HL); const bf16* PFp = WSP(bf16, WS_PF); const bf16* PBp = WSP(bf16, WS_PB); const bf16* GA = WSP(bf16, WS_GA); bf16* A2 = WSP(bf16, WS_A2);
    LAS float* CF = (LAS float*)(F.lds); LAS float* CB = CF + AW;
    for (int u = blockIdx.x; u < NB * 32; u += F.G) {
        const int b = u >> 5, lc = u & 31, ch = tid;
        { float c = 0.f;
          for (int s = 0; s < 4 + lc; ++s) c = AGG[agg_idx(b, s, 0, 0) + ch] * c + AGG[agg_idx(b, s, 0, 1) + ch];
          CF[ch] = c;
          c = 0.f;
          for (int s = 3; s >= 0; --s) c = AGG[agg_idx(b, s, 1, 0) + ch] * c + AGG[agg_idx(b, s, 1, 1) + ch];
          for (int s = NSLOT - 1; s > 4 + lc; --s) c = AGG[agg_idx(b, s, 1, 0) + ch] * c + AGG[agg_idx(b, s, 1, 1) + ch];
          CB[ch] = c; }
        __syncthreads();
        { const int c8 = lane; float cf[8], cb[8];
#pragma unroll
          for (int q = 0; q < 8; ++q) { cf[q] = CF[c8 * 8 + q]; cb[q] = CB[c8 * 8 + q]; }
#pragma unroll 2
          for (int q8 = 0; q8 < 8; ++q8) { const int row = b * SEQ + lc * 64 + wave * 8 + q8; const size_t go = (size_t)row * AW + c8 * 8;
              float hl[8], p1[8], p2[8], ga[8];
              unpack8f(*(const GAS v4u*)(HLp + go), hl); unpack8f(*(const GAS v4u*)(PFp + go), p1); unpack8f(*(const GAS v4u*)(PBp + go), p2); unpack8f(*(const GAS v4u*)(GA + go), ga);
              float r[8];
#pragma unroll
              for (int q = 0; q < 8; ++q) r[q] = (hl[q] + p1[q] * cf[q] + p2[q] * cb[q]) * ga[q];
              v4u o; o.x = pk2(r[0], r[1]); o.y = pk2(r[2], r[3]); o.z = pk2(r[4], r[5]); o.w = pk2(r[6], r[7]);
              *(GAS v4u*)(A2 + (size_t)row * DM + c8 * 8) = o; } }
        __syncthreads();
    }
}


constexpr int P11_WS = 0, P11_VT = 34816, P11_OUT = 52224, P11_BS = 70656;
constexpr int P11_CS = 0, P11_OUT2 = 69632;
constexpr int P11_PITCH = 272;

DEV void mix1_phase(Frame& F) {
    const int tid = F.tid, lane = F.lane, wave = F.wave, bx = blockIdx.x, fr = lane & 15, fq = lane >> 4;
    const int h = bx & 7;
    {
        const float* ws = F.in[26] + (size_t)h * CHUNK * CHUNK;
        for (int idx = tid; idx < CHUNK * CHUNK / 2; idx += 512) { const int p = idx >> 6, q2 = idx & 63;
            *(LAS unsigned*)(F.lds + P11_WS + p * P11_PITCH + q2 * 4) = pk2(ws[p * CHUNK + 2 * q2], ws[p * CHUNK + 2 * q2 + 1]); }
        if (tid < CHUNK) ((LAS float*)(F.lds + P11_BS))[tid] = F.in[27][h * CHUNK + tid];
        __syncthreads();
    }
    const bf16* U = WSP(bf16, WS_U); const bf16* V = WSP(bf16, WS_V); bf16* A3 = WSP(bf16, WS_A2);
    const float* ln_g = F.in[24]; const float* ln_b = F.in[25];
    for (int i = 0; i < 4; ++i) {
        const int u = bx + 256 * i, bn = u >> 3, r0 = bn * CHUNK;
        { float gg[8], bb[8];
#pragma unroll
          for (int j = 0; j < 8; ++j) { gg[j] = ln_g[8 * lane + j]; bb[j] = ln_b[8 * lane + j]; }
          for (int tk = 0; tk < 16; ++tk) { const int q = 16 * wave + tk;
              float v[8]; unpack8f(*(const GAS v4u*)(V + (size_t)(r0 + q) * CWD + 8 * lane), v);
              float s = 0.f;
#pragma unroll
              for (int j = 0; j < 8; ++j) s += v[j];
              const float mu = wave_sum_all(s) * (1.f / CWD);
              float s2 = 0.f;
#pragma unroll
              for (int j = 0; j < 8; ++j) { v[j] -= mu; s2 += v[j] * v[j]; }
              const float rs = rsqrtf(wave_sum_all(s2) * (1.f / CWD) + LN_EPS);
              if ((lane >> 3) == h) { const int d0 = 8 * (lane & 7);
#pragma unroll
                  for (int j = 0; j < 8; ++j) *(LAS bf16*)(F.lds + P11_VT + (d0 + j) * P11_PITCH + q * 2) = f2bf(v[j] * rs * gg[j] + bb[j]); } } }
        __syncthreads();
        { bf16x8 bfr[4];
#pragma unroll
          for (int ks = 0; ks < 4; ++ks) bfr[ks] = *(const LAS bf16x8*)(F.lds + P11_WS + (16 * wave + fr) * P11_PITCH + (ks * 32 + fq * 8) * 2);
          const int p = 16 * wave + fr; const float bias = ((const LAS float*)(F.lds + P11_BS))[p];
#pragma unroll
          for (int mt = 0; mt < 4; ++mt) { f32x4 acc = {0.f, 0.f, 0.f, 0.f};
#pragma unroll
              for (int ks = 0; ks < 4; ++ks) { const bf16x8 afr = *(const LAS bf16x8*)(F.lds + P11_VT + (16 * mt + fr) * P11_PITCH + (ks * 32 + fq * 8) * 2);
                  acc = __builtin_amdgcn_mfma_f32_16x16x32_bf16(afr, bfr[ks], acc, 0, 0, 0); }
              const int d = 16 * mt + 4 * fq;
              const v2u uw = *(const GAS v2u*)(U + (size_t)(r0 + p) * CWD + h * CHD + d);
              const float u0 = __uint_as_float(uw.x << 16), u1 = __uint_as_float(uw.x & 0xffff0000u), u2 = __uint_as_float(uw.y << 16), u3 = __uint_as_float(uw.y & 0xffff0000u);
              v2u o; o.x = pk2((acc[0] + bias) * u0, (acc[1] + bias) * u1); o.y = pk2((acc[2] + bias) * u2, (acc[3] + bias) * u3);
              *(LAS v2u*)(F.lds + P11_OUT + p * 144 + d * 2) = o; } }
        __syncthreads();
#pragma unroll
        for (int k = 0; k < 2; ++k) { const int c = tid + 512 * k, p = c >> 3, c8 = c & 7;
            *(GAS v4u*)(A3 + (size_t)(r0 + p) * DM + h * CHD + c8 * 8) = *(const LAS v4u*)(F.lds + P11_OUT + p * 144 + c8 * 16); }
    }
    __syncthreads();
    for (int idx = tid; idx < 256 * DGD; idx += 512) { const int k2p = idx >> 7, d = idx & 127, m = ((k2p & 127) * d) & 127; const float ang = (float)m * (1.f / 64.f);
        *(LAS bf16*)(F.lds + P11_CS + k2p * P11_PITCH + d * 2) = f2bf(k2p < 128 ? cospif(ang) : sinpif(ang)); }
    __syncthreads();
    const bf16* Fb = WSP(bf16, WS_F); bf16* ZT = WSP(bf16, WS_ZT);
    for (int i = 0; i < 4; ++i) {
        const int u = bx + 256 * i, b = u >> 7, g = (u >> 5) & 3, l0 = (u & 31) * 64;
        const int mt = wave & 3, nh = wave >> 2;
        bf16x8 afr[4];
#pragma unroll
        for (int ks = 0; ks < 4; ++ks) afr[ks] = *(const GAS bf16x8*)(Fb + (size_t)(b * SEQ + l0 + 16 * mt + fr) * DWD + g * DGD + ks * 32 + fq * 8);
#pragma unroll
        for (int ntl = 0; ntl < 8; ++ntl) { const int nt = nh * 8 + ntl; f32x4 acc = {0.f, 0.f, 0.f, 0.f};
#pragma unroll
            for (int ks = 0; ks < 4; ++ks) { const bf16x8 bfr = *(const LAS bf16x8*)(F.lds + P11_CS + (16 * nt + fr) * P11_PITCH + (ks * 32 + fq * 8) * 2);
                acc = __builtin_amdgcn_mfma_f32_16x16x32_bf16(afr[ks], bfr, acc, 0, 0, 0); }
            v2u o; o.x = pk2(acc[0], acc[1]); o.y = pk2(acc[2], acc[3]);
            *(LAS v2u*)(F.lds + P11_OUT2 + (16 * nt + fr) * 144 + (16 * mt + 4 * fq) * 2) = o; }
        __syncthreads();
#pragma unroll
        for (int k = 0; k < 4; ++k) { const int c = tid + 512 * k, k2p = c >> 3, c8 = c & 7, half = k2p >> 7, k2 = k2p & 127;
            *(GAS v4u*)(ZT + (size_t)((b * DGROUPS + g) * DGD + k2) * (2 * SEQ) + half * SEQ + l0 + c8 * 8) = *(const LAS v4u*)(F.lds + P11_OUT2 + k2p * 144 + c8 * 16); }
        __syncthreads();
    }
}

constexpr size_t RT_HIST = 0, RT_TT = 16 * 1024, RT_RE = 64 * 1024, RT_RP = 128 * 1024, RT_SLOT = 256 * 1024;
constexpr int MOE_ROWS = 34816;

DEV void moe_route(Frame& F) {
    const int lane = F.lane, wave = F.wave, tid = F.tid;
    const float* ADA1 = WSP(float, WS_ADA) + 9 * 6 * DM; const float* ng1 = F.in[6] + 4 * DM; const float* router = F.in[29];
    const bf16* Y = WSP(bf16, WS_Y); bf16* H = WSP(bf16, WS_H);
    int* RE = (int*)(F.ws + WS_ROUTE + RT_RE); float* RP = (float*)(F.ws + WS_ROUTE + RT_RP); int* HIST = (int*)(F.ws + WS_ROUTE + RT_HIST);
    LAS int* hist = (LAS int*)(F.lds);
    if (tid < NE) hist[tid] = 0;
    __syncthreads();
    for (int vb = F.vcu; vb < NTOK / 64; vb += F.G) {
        for (int k = 0; k < 8; ++k) {
            const int row = vb * 64 + wave * 8 + k, b = row / SEQ;
            const v2u* yp = (const v2u*)(Y + (size_t)row * DM);
            f32x4 y[4]; float ss = 0.f;
#pragma unroll
            for (int j = 0; j < 4; ++j) { const v2u w = yp[lane + 64 * j]; y[j][0] = __uint_as_float(w.x << 16); y[j][1] = __uint_as_float(w.x & 0xffff0000u); y[j][2] = __uint_as_float(w.y << 16); y[j][3] = __uint_as_float(w.y & 0xffff0000u);
                ss += (y[j][0] * y[j][0] + y[j][1] * y[j][1]) + (y[j][2] * y[j][2] + y[j][3] * y[j][3]); }
            const float ry = rsqrtf(wave_sum_all(ss) * (1.f / DM) + NORM_EPS);
            f32x4* xp = (f32x4*)(F.X + (size_t)row * DM);
            const f32x4* gt = (const f32x4*)(ADA1 + (size_t)b * 6 * DM + 2 * DM); const f32x4* gp = (const f32x4*)(ng1 + 1 * DM);
            f32x4 x[4]; float sx = 0.f;
#pragma unroll
            for (int j = 0; j < 4; ++j) { x[j] = xp[lane + 64 * j] + gt[lane + 64 * j] * (y[j] * ry * gp[lane + 64 * j]); xp[lane + 64 * j] = x[j];
                sx += (x[j][0] * x[j][0] + x[j][1] * x[j][1]) + (x[j][2] * x[j][2] + x[j][3] * x[j][3]); }
            const float rx = rsqrtf(wave_sum_all(sx) * (1.f / DM) + NORM_EPS);
            const f32x4* sh = (const f32x4*)(ADA1 + (size_t)b * 6 * DM + 3 * DM); const f32x4* sc = (const f32x4*)(ADA1 + (size_t)b * 6 * DM + 4 * DM); const f32x4* g4 = (const f32x4*)(ng1 + 2 * DM);
            v2u* ho = (v2u*)(H + (size_t)row * DM);
            float lg[NE];
#pragma unroll
            for (int e = 0; e < NE; ++e) lg[e] = 0.f;
#pragma unroll
            for (int j = 0; j < 4; ++j) { const f32x4 hv = (x[j] * rx * g4[lane + 64 * j]) * (1.f + sc[lane + 64 * j]) + sh[lane + 64 * j];
                v2u o; o.x = pk2(hv[0], hv[1]); o.y = pk2(hv[2], hv[3]); ho[lane + 64 * j] = o;
#pragma unroll
                for (int q = 0; q < 4; ++q) { const f32x4* rr = (const f32x4*)(router + (size_t)(4 * (lane + 64 * j) + q) * NE); const f32x4 r0 = rr[0], r1 = rr[1];
                    lg[0] += hv[q] * r0[0]; lg[1] += hv[q] * r0[1]; lg[2] += hv[q] * r0[2]; lg[3] += hv[q] * r0[3];
                    lg[4] += hv[q] * r1[0]; lg[5] += hv[q] * r1[1]; lg[6] += hv[q] * r1[2]; lg[7] += hv[q] * r1[3]; } }
#pragma unroll
            for (int e = 0; e < NE; ++e) lg[e] = wave_sum_all(lg[e]);
            int i1 = 0; float v1 = lg[0];
#pragma unroll
            for (int e = 1; e < NE; ++e) if (lg[e] > v1) { v1 = lg[e]; i1 = e; }
            int i2 = -1; float v2 = -3.0e38f;
#pragma unroll
            for (int e = 0; e < NE; ++e) if (e != i1 && lg[e] > v2) { v2 = lg[e]; i2 = e; }
            const float p2 = 1.f / (1.f + expf(v1 - v2)), p1 = 1.f - p2;
            if (lane == 0) { RE[row] = i1 | (i2 << 8); RP[2 * row] = p1; RP[2 * row + 1] = p2; atomicAdd((int*)&hist[i1], 1); atomicAdd((int*)&hist[i2], 1); }
        }
        __syncthreads();
        if (tid < NE) { HIST[vb * NE + tid] = hist[tid]; hist[tid] = 0; }
        __syncthreads();
    }
}
DEV void moe_gather(Frame& F) {
    const int tid = F.tid;
    const int* HIST = (const int*)(F.ws + WS_ROUTE + RT_HIST); const int* RE = (const int*)(F.ws + WS_ROUTE + RT_RE);
    int* TT = (int*)(F.ws + WS_ROUTE + RT_TT); int* SLOT = (int*)(F.ws + WS_ROUTE + RT_SLOT);
    const bf16* H = WSP(bf16, WS_H); bf16* HG = WSP(bf16, WS_HG);
    LAS int* tot = (LAS int*)(F.lds);
    LAS int* before = tot + 8;
    LAS int* ent = tot + 16;
    LAS int* slot = tot + 16 + 128;
    for (int vb = F.vcu; vb < NTOK / 64; vb += F.G) {
        if (tid < NE) { int t = 0, bf = 0; for (int k = 0; k < NTOK / 64; ++k) { const int c = HIST[k * NE + tid]; t += c; bf += (k < vb) ? c : 0; } tot[tid] = t; before[tid] = bf; }
        if (tid >= 64 && tid < 128) { const int t = tid - 64; const int re = RE[vb * 64 + t]; ent[2 * t] = re & 0xff; ent[2 * t + 1] = (re >> 8) & 0xff; }
        __syncthreads();
        if (tid < 128) { const int e = ent[tid]; int rank = 0; for (int k = 0; k < tid; ++k) rank += (ent[k] == e) ? 1 : 0;
            int base = 0; for (int k = 0; k < e; ++k) base += ((tot[k] + 255) >> 8) << 8;
            const int s = base + before[e] + rank; slot[tid] = s; SLOT[(vb * 64) * 2 + tid] = s; }
        if (vb == 0 && tid == 128) { int nt = 0; for (int e = 0; e < NE; ++e) { const int n = (tot[e] + 255) >> 8; for (int k = 0; k < n; ++k) TT[1 + nt + k] = e; nt += n; } TT[0] = nt; }
        __syncthreads();
        for (int c = tid; c < 128 * 128; c += 512) { const int en = c >> 7, ck = c & 127;
            *(GAS v4u*)(HG + (size_t)slot[en] * DM + ck * 8) = *(const GAS v4u*)(H + (size_t)(vb * 64 + (en >> 1)) * DM + ck * 8); }
        __syncthreads();
    }
}
namespace pg8 {
struct MoeOrder : StaticOrder {
    const int* tt;
    __device__ __forceinline__ bool next(int i, Unit& u) const { if (!StaticOrder::next(i, u)) return false; u.e = tt[1 + u.pm]; return true; }
};
}
DEV void moe_final(Frame& F) {
    const int lane = F.lane, gw = F.vcu * 8 + F.wave, NGW = F.G * 8;
    const float* ADA1 = WSP(float, WS_ADA) + 9 * 6 * DM; const float* ng1 = F.in[6] + 4 * DM;
    const bf16* YP = WSP(bf16, WS_HG); const int* SLOT = (const int*)(F.ws + WS_ROUTE + RT_SLOT); const float* RP = (const float*)(F.ws + WS_ROUTE + RT_RP);
    for (int row = gw; row < NTOK; row += NGW) {
        const int b = row / SEQ, s1 = SLOT[2 * row], s2 = SLOT[2 * row + 1]; const float p1 = RP[2 * row], p2 = RP[2 * row + 1];
        const v2u* y1 = (const v2u*)(YP + (size_t)s1 * DM); const v2u* y2 = (const v2u*)(YP + (size_t)s2 * DM);
        f32x4 y[4]; float ss = 0.f;
#pragma unroll
        for (int j = 0; j < 4; ++j) { const v2u w = y1[lane + 64 * j], z = y2[lane + 64 * j];
            y[j][0] = p1 * __uint_as_float(w.x << 16) + p2 * __uint_as_float(z.x << 16); y[j][1] = p1 * __uint_as_float(w.x & 0xffff0000u) + p2 * __uint_as_float(z.x & 0xffff0000u);
            y[j][2] = p1 * __uint_as_float(w.y << 16) + p2 * __uint_as_float(z.y << 16); y[j][3] = p1 * __uint_as_float(w.y & 0xffff0000u) + p2 * __uint_as_float(z.y & 0xffff0000u);
            ss += (y[j][0] * y[j][0] + y[j][1] * y[j][1]) + (y[j][2] * y[j][2] + y[j][3] * y[j][3]); }
        const float ry = rsqrtf(wave_sum_all(ss) * (1.f / DM) + NORM_EPS);
        f32x4* xp = (f32x4*)(F.X + (size_t)row * DM);
        const f32x4* gt = (const f32x4*)(ADA1 + (size_t)b * 6 * DM + 5 * DM); const f32x4* gp = (const f32x4*)(ng1 + 3 * DM);
#pragma unroll
        for (int j = 0; j < 4; ++j) xp[lane + 64 * j] = xp[lane + 64 * j] + gt[lane + 64 * j] * (y[j] * ry * gp[lane + 64 * j]);
    }
}

constexpr int NPHASE = 19;
__global__ void __launch_bounds__(512, 2) mega_fwd(Args args) {
    extern __shared__ __attribute__((aligned(16))) unsigned char lds[];
    Frame F;
    F.lds = (LAS unsigned char*)lds;
    F.MISC = (volatile LAS unsigned*)(F.lds + MISC_OFF);
    F.tid = threadIdx.x; F.lane = F.tid & 63; F.wave = __builtin_amdgcn_readfirstlane(F.tid >> 6);
    F.G = gridDim.x; { const int bx = blockIdx.x; F.vcu = (F.G % 8 == 0) ? (bx % 8) * (F.G / 8) + bx / 8 : bx; }
    F.in = args.in; F.X = args.out; F.ws = args.ws; F.ctl = (unsigned*)(args.ws + WS_CTL);
    for (int u = F.tid; u < (LDS_BYTES - LDSCTL_OFF) / 4; u += 512) ((LAS unsigned*)(F.lds + LDSCTL_OFF))[u] = 0u;
    __syncthreads();
    const int lo = args.ph_lo, hi = args.ph_hi;
    XcdBarrier bar; bar.bar = F.ctl + CW_BAR; bar.x = 0; bar.st = nullptr;
    if (hi - lo > 1) bar = xcd_barrier_post(F.ctl + CW_BAR, F.MISC + 8);
#define IN(k) (lo <= (k) && (k) < hi)
#define SEAM(k) do { if (IN(k) && IN((k) + 1)) xcd_barrier(bar); } while (0)
    const float* ADA0 = WSP(float, WS_ADA); const float* ADA1 = ADA0 + 9 * 6 * DM;
    const float* ng0 = F.in[6]; const float* ng1 = F.in[6] + 4 * DM;

    if (IN(0)) { p0_prologue(F); } SEAM(0);
    if (IN(1)) { p1_rows(F); } SEAM(1);
    if (IN(2)) {
        pg8::Gemm g{WSP(bf16, WS_H), WSP(bf16, WS_WIN0), NROWS, 2048, DM, 0}; pg8::StaticOrder S; S.init(NROWS, 2048, F.G, (int)blockIdx.x);
        pg8::EpiIn0 E{WSP(bf16, WS_XARAW), WSP(bf16, WS_GA), WSP(bf16, WS_GLU)};
        pg8::gemm_phase<pg8::EpiIn0, pg8::StaticOrder, true, true>(F.lds, g, S, E);
    } SEAM(2);
    MIX0_PHASES
    if (IN(5)) {
        pg8::Gemm g{WSP(bf16, WS_A2), WSP(bf16, WS_WOUT0), NTOK, DM, DM, 0}; pg8::StaticOrder S; S.init(NTOK, DM, F.G, (int)blockIdx.x);
        pg8::EpiBf16<0> E{WSP(bf16, WS_Y), DM, nullptr, 0, 0, 1.f};
        pg8::gemm_phase<pg8::EpiBf16<0>, pg8::StaticOrder, true, true>(F.lds, g, S, E);
    } SEAM(5);
    if (IN(6)) { thin_rows(F, WSP(bf16, WS_Y), ng0 + 1 * DM, ADA0, 2 * DM, ng0 + 2 * DM, ADA0, 3 * DM, 4 * DM); } SEAM(6);
    if (IN(7)) {
        pg8::Gemm g{WSP(bf16, WS_H), WSP(bf16, WS_W13), NTOK, 2 * DFF, DM, 0}; pg8::StaticOrder S; S.init(NTOK, 2 * DFF, F.G, (int)blockIdx.x);
        pg8::EpiSwiglu E{WSP(bf16, WS_ACT), DFF, 0};
        pg8::gemm_phase<pg8::EpiSwiglu, pg8::StaticOrder, true, true>(F.lds, g, S, E);
    } SEAM(7);
    if (IN(8)) {
        pg8::Gemm g{WSP(bf16, WS_ACT), WSP(bf16, WS_W2), NTOK, DM, DFF, 0}; pg8::StaticOrder S; S.init(NTOK, DM, F.G, (int)blockIdx.x);
        pg8::EpiBf16<0> E{WSP(bf16, WS_Y), DM, nullptr, 0, 0, 1.f};
        pg8::gemm_phase<pg8::EpiBf16<0>, pg8::StaticOrder, true, true>(F.lds, g, S, E);
    } SEAM(8);
    if (IN(9)) { thin_rows(F, WSP(bf16, WS_Y), ng0 + 3 * DM, ADA0, 5 * DM, ng1 + 0 * DM, ADA1, 0 * DM, 1 * DM); } SEAM(9);
    if (IN(10)) {
        pg8::Gemm g{WSP(bf16, WS_H), WSP(bf16, WS_CDIN), NTOK, 1536, DM, 0}; pg8::StaticOrder S; S.init(NTOK, 1536, F.G, (int)blockIdx.x);
        pg8::EpiIn1 E{WSP(bf16, WS_U), (size_t)(WS_V - WS_U) / 2};
        pg8::gemm_phase<pg8::EpiIn1, pg8::StaticOrder, true, true>(F.lds, g, S, E);
    } SEAM(10);
    MIX1_PHASES
    if (IN(12)) {
        pg8::Gemm g{WSP(bf16, WS_DFTA), WSP(bf16, WS_ZT), SEQ, 4096, 2 * SEQ, 0}; pg8::StaticOrder S; S.init(SEQ, 4096, F.G, (int)blockIdx.x);
        pg8::EpiDft E{WSP(bf16, WS_A2)};
        pg8::gemm_phase<pg8::EpiDft, pg8::StaticOrder, true, true>(F.lds, g, S, E);
    } SEAM(12);
    if (IN(13)) {
        pg8::Gemm g{WSP(bf16, WS_A2), WSP(bf16, WS_CDOUT), NTOK, DM, DM, 0}; pg8::StaticOrder S; S.init(NTOK, DM, F.G, (int)blockIdx.x);
        pg8::EpiBf16<0> E{WSP(bf16, WS_Y), DM, nullptr, 0, 0, 1.f};
        pg8::gemm_phase<pg8::EpiBf16<0>, pg8::StaticOrder, true, true>(F.lds, g, S, E);
    } SEAM(13);
    MOE_PHASES
#undef IN
#undef SEAM
}

static inline unsigned cdiv(size_t a, size_t b) { return (unsigned)((a + b - 1) / b); }

extern "C" void kernel_launch(void* const* d_in, const int* in_sizes, int n_in, void* d_out, int out_size, void* d_ws, size_t ws_size, hipStream_t stream) {
    static int grid = 0;
    if (grid == 0) {
        if (n_in != 33 || ws_size < WS_END || out_size != NTOK * DM) { fprintf(stderr, "kernel_launch: unexpected n_in %d / ws_size %zu / out_size %d\n", n_in, ws_size, out_size); grid = -1; return; }
        int dev = 0, cus = 0, per_cu = 0;
        if (hipGetDevice(&dev) != hipSuccess || hipDeviceGetAttribute(&cus, hipDeviceAttributeMultiprocessorCount, dev) != hipSuccess) { grid = -1; return; }
        if (hipFuncSetAttribute((const void*)mega_fwd, hipFuncAttributeMaxDynamicSharedMemorySize, LDS_BYTES) != hipSuccess) { fprintf(stderr, "kernel_launch: hipFuncSetAttribute failed\n"); grid = -1; return; }
        if (hipOccupancyMaxActiveBlocksPerMultiprocessor(&per_cu, (const void*)mega_fwd, 512, LDS_BYTES) != hipSuccess || per_cu < 1) { fprintf(stderr, "kernel_launch: occupancy query says %d\n", per_cu); }
        (void)hipGetLastError();
        grid = cus;
    }
    if (grid < 0) return;
    const float* x = (const float*)d_in[0]; const float* c = (const float*)d_in[1]; const float* ctx = (const float*)d_in[2]; const float* c_ctx = (const float*)d_in[3];
    const float* ada_w = (const float*)d_in[4]; const float* ada_b = (const float*)d_in[5]; const float* norm_g = (const float*)d_in[6];
    const float* ab_w_in = (const float*)d_in[7]; const float* rg_conv_w = (const float*)d_in[8]; const float* rg_conv_b = (const float*)d_in[9];
    const float* rg_w_r = (const float*)d_in[10]; const float* rg_b_r = (const float*)d_in[11]; const float* rg_w_i = (const float*)d_in[12]; const float* rg_b_i = (const float*)d_in[13];
    const float* rg_lambda = (const float*)d_in[14]; const float* cv_dw_w = (const float*)d_in[15]; const float* cv_dw_b = (const float*)d_in[16];
    const float* cv_ln_g = (const float*)d_in[17]; const float* cv_ln_b = (const float*)d_in[18]; const float* ab_w_out = (const float*)d_in[19];
    const float* ffn_w1 = (const float*)d_in[20]; const float* ffn_w3 = (const float*)d_in[21]; const float* ffn_w2 = (const float*)d_in[22];
    const float* cd_w_in = (const float*)d_in[23]; const float* sg_ln_g = (const float*)d_in[24]; const float* sg_ln_b = (const float*)d_in[25];
    const float* sg_w_s = (const float*)d_in[26]; const float* sg_b_s = (const float*)d_in[27]; const float* cd_w_out = (const float*)d_in[28];
    const float* moe_router = (const float*)d_in[29]; const float* moe_w1 = (const float*)d_in[30]; const float* moe_w3 = (const float*)d_in[31]; const float* moe_w2 = (const float*)d_in[32];
    float* X = (float*)d_out;
    unsigned char* ws = (unsigned char*)d_ws;
    float* ADA = (float*)(ws + WS_ADA); float* GATE = (float*)(ws + WS_ROUTE);
    bf16* WIN0 = (bf16*)(ws + WS_WIN0); bf16* WOUT0 = (bf16*)(ws + WS_WOUT0); bf16* W13 = (bf16*)(ws + WS_W13); bf16* W2 = (bf16*)(ws + WS_W2);
    bf16* CDIN = (bf16*)(ws + WS_CDIN); bf16* CDOUT = (bf16*)(ws + WS_CDOUT); bf16* DFTA = (bf16*)(ws + WS_DFTA); bf16* MW13 = (bf16*)(ws + WS_MW13); bf16* MW2 = (bf16*)(ws + WS_MW2);
    bf16* H = (bf16*)(ws + WS_H); bf16* Y = (bf16*)(ws + WS_Y);
    bf16* XA_RAW = (bf16*)(ws + WS_XARAW); bf16* GA = (bf16*)(ws + WS_GA); bf16* GLU = (bf16*)(ws + WS_GLU); bf16* A2 = (bf16*)(ws + WS_A2);
    float* XA = (float*)(ws + WS_NXA); float* HSUM = (float*)(ws + WS_NHSUM); float* U31 = (float*)(ws + WS_Y);
    bf16* ACT = (bf16*)(ws + WS_ACT);
    bf16* U = (bf16*)(ws + WS_U); bf16* V = (bf16*)(ws + WS_V); bf16* F = (bf16*)(ws + WS_F); bf16* A3 = A2; float* VLN = (float*)(ws + WS_NVLN); bf16* ZT = (bf16*)(ws + WS_ZT);
    float* OUTMOE = (float*)(ws + WS_NOUTMOE); bf16* ACTE = (bf16*)(ws + WS_NACTE);
    const float* ADA0 = ADA; const float* ADA1 = ADA + 9 * 6 * DM;
    const float* ng0 = norm_g; const float* ng1 = norm_g + 4 * DM;

    if (hipMemsetAsync((char*)d_ws + WS_CTL, 0, CTL_ZERO_BYTES, stream) != hipSuccess) return;
    Args a{};
    for (int i = 0; i < 33; ++i) a.in[i] = (const float*)d_in[i];
    a.out = X; a.ws = ws;
    auto mega = [&](int lo, int hi) { a.ph_lo = lo; a.ph_hi = hi; hipLaunchKernelGGL(mega_fwd, dim3(grid), dim3(512), LDS_BYTES, stream, a); };
    auto wt = [&](const float* W, int ldw, int col0, int ncols, int K, bf16* Wt, int row_off, int mode, int half) {
        k_wt<<<cdiv((size_t)ncols * K, 256), 256, 0, stream>>>(W, ldw, col0, ncols, K, Wt, row_off, mode, half);
    };
    static const int MEGA[NPHASE] = {MEGA_MASK};
#if MEGA_ONE_LAUNCH
    mega(0, NPHASE);
    return;
#endif
    if (MEGA[0]) mega(0, 1);
    else {
        k_ada<<<cdiv(2 * 9 * 6 * DM, 256), 256, 0, stream>>>(c, c_ctx, ada_w, ada_b, ADA);
        wt(ab_w_in, 2048, 0, 1024, DM, WIN0, 0, 0, 0); wt(ab_w_in, 2048, 1024, 512, DM, WIN0, 1024, 1, 0); wt(ab_w_in, 2048, 1536, 512, DM, WIN0, 1024, 1, 1);
        wt(ab_w_out, DM, 0, DM, DM, WOUT0, 0, 0, 0);
        wt(ffn_w1, DFF, 0, DFF, DM, W13, 0, 1, 0); wt(ffn_w3, DFF, 0, DFF, DM, W13, 0, 1, 1); wt(ffn_w2, DM, 0, DM, DFF, W2, 0, 0, 0);
        wt(cd_w_in, 1536, 0, 1536, DM, CDIN, 0, 0, 0); wt(cd_w_out, DM, 0, DM, DM, CDOUT, 0, 0, 0);
        for (int e = 0; e < NE; ++e) {
            wt(moe_w1 + (size_t)e * DM * DFE, DFE, 0, DFE, DM, MW13 + (size_t)e * 2 * DFE * DM, 0, 1, 0);
            wt(moe_w3 + (size_t)e * DM * DFE, DFE, 0, DFE, DM, MW13 + (size_t)e * 2 * DFE * DM, 0, 1, 1);
            wt(moe_w2 + (size_t)e * DFE * DM, DM, 0, DM, DFE, MW2 + (size_t)e * DM * DFE, 0, 0, 0);
        }
        k_dftmat<<<cdiv((size_t)SEQ * SEQ, 256), 256, 0, stream>>>(DFTA);
    }
    if (MEGA[1]) mega(1, 2);
    else {
        k_posadd<<<cdiv((size_t)NTOK * DM, 256), 256, 0, stream>>>(x, X);
        k_norm_mod<<<NTOK, 256, 0, stream>>>(X, H, SEQ, ng0 + 0 * DM, ADA0, 0 * DM, 1 * DM, -1);
        k_norm_mod<<<NCTX, 256, 0, stream>>>(ctx, H + (size_t)NTOK * DM, CTXL, ng0 + 0 * DM, ADA0, 0 * DM, 1 * DM, 8);
    }
    if (MEGA[2]) mega(2, 3);
    else {
        k_gemm<false, EpIn0><<<dim3(1024 / 64, NROWS / 32), 256, 0, stream>>>(H, WIN0, DM, nullptr, EpIn0{XA_RAW, GA});
        k_gemm<true, EpGlu><<<dim3(512 / 64, NTOK / 32), 256, 0, stream>>>(H, WIN0 + (size_t)1024 * DM, DM, nullptr, EpGlu{GLU, BWD, 0});
    }
    if (MEGA[3]) mega(3, 4);
    if (MEGA[4]) mega(4, 5);
    if (!MEGA[3] && !MEGA[4]) {
        k_conv4<<<cdiv((size_t)NROWS * AW, 256), 256, 0, stream>>>(XA_RAW, rg_conv_w, rg_conv_b, XA);
        k_scan<<<NB * AHEADS, 64, 0, stream>>>(XA, rg_w_r, rg_b_r, rg_w_i, rg_b_i, rg_lambda, GA, HSUM, A2, 0);
        k_scan<<<NB * AHEADS, 64, 0, stream>>>(XA, rg_w_r, rg_b_r, rg_w_i, rg_b_i, rg_lambda, GA, HSUM, A2, 1);
        k_conv31<<<cdiv((size_t)NTOK * BWD, 256), 256, 0, stream>>>(GLU, cv_dw_w, cv_dw_b, U31);
        k_ln_silu<<<NTOK, 256, 0, stream>>>(U31, cv_ln_g, cv_ln_b, A2);
    }
    if (MEGA[5]) mega(5, 6);
    else k_gemm<false, EpPlainBf16><<<dim3(DM / 64, NTOK / 32), 256, 0, stream>>>(A2, WOUT0, DM, nullptr, EpPlainBf16{Y, DM, 0});
    if (MEGA[6]) mega(6, 7);
    else {
        k_resid<bf16><<<NTOK, 256, 0, stream>>>(Y, X, ng0 + 1 * DM, ADA0, 2 * DM);
        k_norm_mod<<<NTOK, 256, 0, stream>>>(X, H, SEQ, ng0 + 2 * DM, ADA0, 3 * DM, 4 * DM, -1);
    }
    if (MEGA[7]) mega(7, 8);
    else k_gemm<true, EpSwiglu><<<dim3(DFF / 64, NTOK / 32), 256, 0, stream>>>(H, W13, DM, nullptr, EpSwiglu{ACT, DFF, 0});
    if (MEGA[8]) mega(8, 9);
    else k_gemm<false, EpPlainBf16><<<dim3(DM / 64, NTOK / 32), 256, 0, stream>>>(ACT, W2, DFF, nullptr, EpPlainBf16{Y, DM, 0});
    if (MEGA[9]) mega(9, 10);
    else {
        k_resid<bf16><<<NTOK, 256, 0, stream>>>(Y, X, ng0 + 3 * DM, ADA0, 5 * DM);
        k_norm_mod<<<NTOK, 256, 0, stream>>>(X, H, SEQ, ng1 + 0 * DM, ADA1, 0 * DM, 1 * DM, -1);
    }
    if (MEGA[10]) mega(10, 11);
    else k_gemm<false, EpIn1><<<dim3(1536 / 64, NTOK / 32), 256, 0, stream>>>(H, CDIN, DM, nullptr, EpIn1{U, V, F});
    if (MEGA[11]) mega(11, 12);
    else {
        k_ln_v<<<NTOK, 256, 0, stream>>>(V, sg_ln_g, sg_ln_b, VLN);
        k_sgate<<<cdiv((size_t)NTOK * CWD, 256), 256, 0, stream>>>(U, VLN, sg_w_s, sg_b_s, A3);
        k_chandft<<<cdiv((size_t)NB * DGROUPS * DGD * SEQ, 256), 256, 0, stream>>>(F, ZT);
    }
    if (MEGA[12]) mega(12, 13);
    else k_gemm<false, EpDft><<<dim3(4096 / 64, SEQ / 32), 256, 0, stream>>>(DFTA, ZT, 2 * SEQ, nullptr, EpDft{A3});
    if (MEGA[13]) mega(13, 14);
    else k_gemm<false, EpPlainBf16><<<dim3(DM / 64, NTOK / 32), 256, 0, stream>>>(A3, CDOUT, DM, nullptr, EpPlainBf16{Y, DM, 0});
    if (MEGA[14]) { for (int p = 14; p < NPHASE; ++p) mega(p, p + 1); }
    else {
        k_resid<bf16><<<NTOK, 256, 0, stream>>>(Y, X, ng1 + 1 * DM, ADA1, 2 * DM);
        k_norm_mod_route<<<NTOK, 256, 0, stream>>>(X, H, ng1 + 2 * DM, ADA1, 3 * DM, 4 * DM, moe_router, GATE);
        (void)hipMemsetAsync(OUTMOE, 0, (size_t)NTOK * DM * 4, stream);
        for (int e = 0; e < NE; ++e) {
            const float* gate = GATE + (size_t)e * NTOK;
            k_gemm<true, EpSwiglu><<<dim3(DFE / 64, NTOK / 32), 256, 0, stream>>>(H, MW13 + (size_t)e * 2 * DFE * DM, DM, gate, EpSwiglu{ACTE, DFE, 0});
            k_gemm<false, EpMoe2><<<dim3(DM / 64, NTOK / 32), 256, 0, stream>>>(ACTE, MW2 + (size_t)e * DM * DFE, DFE, gate, EpMoe2{OUTMOE, gate});
        }
        k_resid<float><<<NTOK, 256, 0, stream>>>(OUTMOE, X, ng1 + 3 * DM, ADA1, 5 * DM);
    }
}
```

```cpp
#include <hip/hip_runtime.h>
#include <cstdint>
#include <cstdio>

typedef unsigned short bf16;
#define DEV __device__ __forceinline__

constexpr int NB = 8, SEQ = 2048, DM = 1024, CTXL = 256, GRIDW = 64;
constexpr int NTOK = NB * SEQ;
constexpr int NCTX = NB * CTXL;
constexpr int NROWS = NTOK + NCTX;
constexpr int AW = 512, AHEADS = 8, AHD = 64, BWD = 512, CONVB = 31;
constexpr int CWD = 512, CHEADS = 8, CHD = 64, CHUNK = 128, DWD = 512, DGROUPS = 4, DGD = 128;
constexpr int DFF = 2816, NE = 8, DFE = 3584;
constexpr float NORM_EPS = 1e-6f, LN_EPS = 1e-5f;

DEV float bf2f(bf16 h) { return __uint_as_float((unsigned)h << 16); }
DEV bf16 f2bf(float f) { unsigned u = __float_as_uint(f); return (bf16)((u + 0x7fffu + ((u >> 16) & 1u)) >> 16); }
DEV float sigmoid_f(float x) { return 1.f / (1.f + expf(-x)); }
DEV float silu_f(float x) { return x * sigmoid_f(x); }
DEV float gelu_tanh_f(float x) { const float u = 0.7978845608028654f * (x + 0.044715f * x * x * x); return 0.5f * x * (1.f + tanhf(u)); }
DEV float softplus_f(float x) { return x > 20.f ? x : log1pf(expf(x)); }
DEV float wave_sum(float v) {
#pragma unroll
    for (int o = 32; o > 0; o >>= 1) v += __shfl_xor(v, o);
    return v;
}
template <int NW> DEV float block_sum(float v, float* sm) {
    v = wave_sum(v);
    __syncthreads();
    if ((threadIdx.x & 63) == 0) sm[threadIdx.x >> 6] = v;
    __syncthreads();
    float t = 0.f;
#pragma unroll
    for (int i = 0; i < NW; ++i) t += sm[i];
    return t;
}

#define MIX0_PHASES if (IN(3)) { mix0_local(F); } SEAM(3); if (IN(4)) { mix0_carry(F); } SEAM(4);
#define MIX1_PHASES if (IN(11)) { mix1_phase(F); } SEAM(11);
#define MOE_PHASES \
    if (IN(14)) { moe_route(F); } SEAM(14); \
    if (IN(15)) { moe_gather(F); } SEAM(15); \
    if (IN(16)) { const int* TT = (const int*)(F.ws + WS_ROUTE + RT_TT); const int ntl = TT[0]; \
        pg8::Gemm g{(const bf16*)(F.ws + WS_HG), (const bf16*)(F.ws + WS_MW13), ntl * 256, 2 * DFE, DM / 2, (size_t)2 * DFE * DM}; pg8::MoeOrder S; S.init(ntl * 256, 2 * DFE, F.G, (int)blockIdx.x); S.tt = TT; \
        pg8::EpiSwigluS<MOE_G2_FP8 != 0> E{(void*)(F.ws + WS_ACTM), DFE, 1.f / MOE_W13_SCALE, MOE_G2_FP8 ? MOE_ACT_SCALE : 1.f, 0}; \
        pg8::gemm_phase<pg8::EpiSwigluS<MOE_G2_FP8 != 0>, pg8::MoeOrder, true, true, true>(F.lds, g, S, E); } SEAM(16); \
    if (IN(17)) { const int* TT = (const int*)(F.ws + WS_ROUTE + RT_TT); const int ntl = TT[0]; \
        if (MOE_G2_FP8) { pg8::Gemm g{(const bf16*)(F.ws + WS_ACTM), (const bf16*)(F.ws + WS_MW2), ntl * 256, DM, DFE / 2, (size_t)DM * DFE}; pg8::MoeOrder S; S.init(ntl * 256, DM, F.G, (int)blockIdx.x); S.tt = TT; \
            pg8::EpiScaleBf16 E{WSP(bf16, WS_YP), DM, 1.f / (MOE_W2_SCALE * MOE_ACT_SCALE)}; \
            pg8::gemm_phase<pg8::EpiScaleBf16, pg8::MoeOrder, true, true, true>(F.lds, g, S, E); } \
        else { pg8::Gemm g{WSP(bf16, WS_ACTM), WSP(bf16, WS_MW2), ntl * 256, DM, DFE, (size_t)DM * DFE * 2}; pg8::MoeOrder S; S.init(ntl * 256, DM, F.G, (int)blockIdx.x); S.tt = TT; \
            pg8::EpiScaleBf16 E{WSP(bf16, WS_YP), DM, 1.f}; \
            pg8::gemm_phase<pg8::EpiScaleBf16, pg8::MoeOrder, true, true, false>(F.lds, g, S, E); } } SEAM(17); \
    if (IN(18)) { moe_final(F); }

namespace pg8 {
#define PG8_LAS __attribute__((address_space(3)))
typedef unsigned short bf16_t;
typedef short bf16x8 __attribute__((ext_vector_type(8)));
typedef float f32x4 __attribute__((ext_vector_type(4)));
typedef unsigned u32x4 __attribute__((ext_vector_type(4)));
typedef int v4i_t __attribute__((ext_vector_type(4)));
typedef int v8i_t __attribute__((ext_vector_type(8)));
constexpr int BM = 256, BK = 64, HALF = 128, HTB = HALF * BK * 2  , STAGE_BYTES = 8 * HTB, NXCD = 8, WGM = 8;

__host__ __device__ __forceinline__ int lds_byte(int r, int c) { const int st = (r >> 4) * 2 + (c >> 5), rr = r & 15, cc = c & 31, ob = rr * 64 + cc * 2; return st * 1024 + (ob ^ (((ob >> 9) & 1) << 5)); }
__host__ __device__ __forceinline__ void stage_rc(int b, int& R, int& C) { const int st = b / 1024, sb = b % 1024, swz = sb ^ (((sb >> 9) & 1) << 5); R = (st >> 1) * 16 + swz / 64; C = (st & 1) * 32 + (swz % 64) / 2; }
__host__ __device__ __forceinline__ int perm32(int rho) { const int n = rho >> 4, i = rho & 15; return 8 * (i >> 2) + 4 * n + (i & 3); }

struct Unit { int pm, pn, e; };
struct Gemm { const bf16_t* A; const bf16_t* Bt; int M, N, K; size_t bstride; };

struct StaticOrder {
    int nM, nN, nwg, G, c;
    __host__ __device__ void init(int M, int N, int G_, int c_) { nM = M / BM; nN = N / BM; nwg = nM * nN; G = G_; c = c_; }
    __host__ __device__ bool next(int i, Unit& u) const {
        const long L = (long)i * G + c; if (L >= nwg) return false;
        int wgid = (int)L; { const int q = nwg / NXCD, r = nwg % NXCD, xcd = wgid % NXCD, off = wgid / NXCD; wgid = (xcd < r ? xcd * (q + 1) : r * (q + 1) + (xcd - r) * q) + off; }
        const int nig = WGM * nN, gid = wgid / nig, fm = gid * WGM, gsz = (nM - fm) < WGM ? (nM - fm) : WGM;
        u.pm = fm + ((wgid % nig) % gsz); u.pn = (wgid % nig) / gsz; u.e = 0; return true;
    }
    __device__ __forceinline__ void a_ready(const Unit&) const {}
    __device__ __forceinline__ void done(const Unit&) const {}
};

__device__ __forceinline__ unsigned cvt_pk_bf16(float lo, float hi) { unsigned r; asm volatile("v_cvt_pk_bf16_f32 %0, %1, %2" : "=v"(r) : "v"(lo), "v"(hi)); return r; }
typedef float f32x2 __attribute__((ext_vector_type(2)));
__device__ __forceinline__ f32x2 gelu_pk(f32x2 v) {
    const f32x2 av = __builtin_elementwise_abs(v), d = av * 0.2316418882f + 1.0f;
    f32x2 t; t.x = __builtin_amdgcn_rcpf(d.x); t.y = __builtin_amdgcn_rcpf(d.y);
    f32x2 q = t * 0.5307027145f + (-0.7265760135f); q = q * t + 0.7107068705f; q = q * t + (-0.142248368f); q = q * t + 0.127414796f; q = q * t;
    const f32x2 s = (v * v) * (-0.72134752044f);
    f32x2 e; e.x = __builtin_amdgcn_exp2f(s.x); e.y = __builtin_amdgcn_exp2f(s.y);
    const f32x2 m = v * (q * e), r = v - m;
    f32x2 o; o.x = v.x < 0.f ? m.x : r.x; o.y = v.y < 0.f ? m.y : r.y; return o;
}

template <int ACT  > struct EpiBf16 {
    static constexpr bool PERM = true, AFTER_DRAIN = false; static_assert(ACT == 0 || ACT == 1, "EpiBf16: ACT is 0 (none) or 1 (gelu_pk)");
    bf16_t* O; int ldc; const float* bias; int split_cols; size_t split_stride; float scale0;
    __device__ __forceinline__ void operator()(const f32x4 (&acc)[2][2][4][2], const Unit& u, int wr, int wc, int fr, int fq) const {
        const int row0 = u.pm * BM + wr * 64 + fr; int colt = u.pn * BM; bf16_t* base = O;
        float sc = 1.f; if (split_cols) { const int t = colt / split_cols; base += (size_t)t * split_stride; colt -= t * split_cols; if (t == 0) sc = scale0; }
        const int col0 = colt + wc * 32 + 8 * fq, bcol0 = u.pn * BM + wc * 32 + 8 * fq;
        f32x4 bv[2][2];
#pragma unroll
        for (int bj = 0; bj < 2; ++bj)
#pragma unroll
            for (int n = 0; n < 2; ++n) bv[bj][n] = bias ? *(const f32x4*)(bias + bcol0 + bj * HALF + 4 * n) : (f32x4){0.f, 0.f, 0.f, 0.f};
#pragma unroll
        for (int ai = 0; ai < 2; ++ai)
#pragma unroll
            for (int m = 0; m < 4; ++m) { bf16_t* rowp = base + (size_t)(row0 + ai * HALF + m * 16) * ldc + col0;
#pragma unroll
                for (int bj = 0; bj < 2; ++bj) { f32x4 v0 = acc[ai][bj][m][0] + bv[bj][0], v1 = acc[ai][bj][m][1] + bv[bj][1];
                    if (ACT == 1) { f32x2 a = gelu_pk((f32x2){v0[0], v0[1]}), b = gelu_pk((f32x2){v0[2], v0[3]}), c = gelu_pk((f32x2){v1[0], v1[1]}), d = gelu_pk((f32x2){v1[2], v1[3]});
                        v0 = (f32x4){a.x, a.y, b.x, b.y}; v1 = (f32x4){c.x, c.y, d.x, d.y}; }
                    v0 = v0 * sc; v1 = v1 * sc; u32x4 w; w.x = cvt_pk_bf16(v0[0], v0[1]); w.y = cvt_pk_bf16(v0[2], v0[3]); w.z = cvt_pk_bf16(v1[0], v1[1]); w.w = cvt_pk_bf16(v1[2], v1[3]);
                    *(u32x4*)(rowp + bj * HALF) = w; } }
    }
};


template <class Epi, class Sched, bool ALIGN_EPI = false, bool SP2 = false, bool FP8 = false>
__device__ __forceinline__ void gemm_phase(PG8_LAS unsigned char* lds, const Gemm g, const Sched& S, const Epi& E) {
    const int tid = threadIdx.x, wid = __builtin_amdgcn_readfirstlane(tid >> 6), lane = tid & 63, wr = wid >> 2, wc = wid & 3, fr = lane & 15, fq = lane >> 4;
    int K = g.K; asm volatile("" : "+s"(K));
    const int nt = K / BK;
    unsigned voffA[2], voffB[2];
#pragma unroll
    for (int i = 0; i < 2; ++i) { int R, C; stage_rc(tid * 16 + i * 8192, R, C); const int Rb = Epi::PERM ? ((R & ~31) + perm32(R & 31)) : R;
        voffA[i] = (unsigned)(R * K + C) * 2u; voffB[i] = (unsigned)(Rb * K + C) * 2u; }
    const size_t kstep = (size_t)(BK * 2);
    const size_t hstep = (size_t)HALF * K * 2;
    const size_t tstep = 2 * hstep;
    const unsigned ldsw = (unsigned)wid * 1024u;
    const int aoff = lds_byte(wr * 64 + fr, fq * 8), boff = lds_byte(wc * 32 + fr, fq * 8);
#define PG8_SA(b, h) (((b) * 2 + (h)) * HTB)
#define PG8_SB(b, h) ((4 + (b) * 2 + (h)) * HTB)
#define PG8_STAGE(bufoff, gbase, voff) do { _Pragma("unroll") for (int _i = 0; _i < 2; ++_i) \
        __builtin_amdgcn_global_load_lds((const unsigned*)((const char*)(gbase) + (voff)[_i]), (PG8_LAS unsigned*)(lds + (bufoff) + ldsw + _i * 8192), 16, 0, 0); } while (0)
#define PG8_LDA(dst, b, h) do { if constexpr (FP8) { _Pragma("unroll") for (int m = 0; m < 4; ++m) dst##8[m] = __builtin_shufflevector(*(const PG8_LAS v4i_t*)(lds + PG8_SA(b, h) + aoff + m * 2048), *(const PG8_LAS v4i_t*)(lds + PG8_SA(b, h) + aoff + m * 2048 + 1024), 0, 1, 2, 3, 4, 5, 6, 7); } \
    else { _Pragma("unroll") for (int m = 0; m < 4; ++m) _Pragma("unroll") for (int k = 0; k < 2; ++k) dst[m][k] = *(const PG8_LAS bf16x8*)(lds + PG8_SA(b, h) + aoff + m * 2048 + k * 1024); } } while (0)
#define PG8_LDB(dst, b, h) do { if constexpr (FP8) { _Pragma("unroll") for (int n = 0; n < 2; ++n) dst##8[n] = __builtin_shufflevector(*(const PG8_LAS v4i_t*)(lds + PG8_SB(b, h) + boff + n * 2048), *(const PG8_LAS v4i_t*)(lds + PG8_SB(b, h) + boff + n * 2048 + 1024), 0, 1, 2, 3, 4, 5, 6, 7); } \
    else { _Pragma("unroll") for (int n = 0; n < 2; ++n) _Pragma("unroll") for (int k = 0; k < 2; ++k) dst[n][k] = *(const PG8_LAS bf16x8*)(lds + PG8_SB(b, h) + boff + n * 2048 + k * 1024); } } while (0)
#define PG8_MMA(ai, bj, At, Bt) do { __builtin_amdgcn_s_setprio(1); \
    if constexpr (FP8) { _Pragma("unroll") for (int m = 0; m < 4; ++m) _Pragma("unroll") for (int n = 0; n < 2; ++n) \
        asm volatile("v_mfma_f32_16x16x128_f8f6f4 %0, %1, %2, %0" : "+v"(acc[ai][bj][m][n]) : "v"(Bt##8[n]), "v"(At##8[m])); } \
    else { _Pragma("unroll") for (int m = 0; m < 4; ++m) _Pragma("unroll") for (int n = 0; n < 2; ++n) _Pragma("unroll") for (int k = 0; k < 2; ++k) \
        acc[ai][bj][m][n] = __builtin_amdgcn_mfma_f32_16x16x32_bf16(Bt[n][k], At[m][k], acc[ai][bj][m][n], 0, 0, 0); } __builtin_amdgcn_s_setprio(0); } while (0)
#define PG8_WAIT_V(n) asm volatile("s_waitcnt vmcnt(" #n ")" ::: "memory")
#define PG8_WAIT_L(n) asm volatile("s_waitcnt lgkmcnt(" #n ")" ::: "memory")
#define PG8_BAR __builtin_amdgcn_s_barrier()
#define PG8_SCHED __builtin_amdgcn_sched_barrier(0)
    Unit cur, nxt; int ui = 0;
    if (!S.next(0, cur)) return;
    f32x4 acc[2][2][4][2];
#pragma unroll
    for (int a = 0; a < 2; ++a)
#pragma unroll
        for (int b = 0; b < 2; ++b)
#pragma unroll
            for (int m = 0; m < 4; ++m)
#pragma unroll
                for (int n = 0; n < 2; ++n) acc[a][b][m][n] = (f32x4){0.f, 0.f, 0.f, 0.f};
    bf16x8 At[4][2], B0[2][2], B1[2][2]; v8i_t At8[4], B08[2], B18[2];
    const char* cA = (const char*)g.A + (size_t)cur.pm * tstep; const char* cB = (const char*)g.Bt + (size_t)cur.pn * tstep + (size_t)cur.e * g.bstride;
    S.a_ready(cur);
    if constexpr (SP2) {
        PG8_STAGE(PG8_SB(0, 0), cB, voffB); PG8_STAGE(PG8_SB(0, 1), cB + hstep, voffB); PG8_STAGE(PG8_SA(0, 0), cA, voffA); PG8_STAGE(PG8_SA(0, 1), cA + hstep, voffA);
        if (wr == 1) PG8_BAR;
        PG8_WAIT_V(2); PG8_BAR;
        PG8_STAGE(PG8_SB(1, 0), cB + kstep, voffB); PG8_STAGE(PG8_SA(1, 0), cA + kstep, voffA); PG8_STAGE(PG8_SB(1, 1), cB + hstep + kstep, voffB);
        PG8_WAIT_V(6); PG8_BAR;
    } else {
        PG8_STAGE(PG8_SB(0, 0), cB, voffB); PG8_STAGE(PG8_SA(0, 0), cA, voffA); PG8_STAGE(PG8_SB(0, 1), cB + hstep, voffB); PG8_STAGE(PG8_SA(0, 1), cA + hstep, voffA);
        if (wr == 1) PG8_BAR;
        PG8_WAIT_V(4); PG8_BAR;
        PG8_STAGE(PG8_SB(1, 0), cB + kstep, voffB); PG8_STAGE(PG8_SA(1, 0), cA + kstep, voffA); PG8_STAGE(PG8_SB(1, 1), cB + hstep + kstep, voffB);
        PG8_WAIT_V(6); PG8_BAR;
    }
    for (;;) {
        const bool has_next = S.next(ui + 1, nxt);
        const char* nA = has_next ? (const char*)g.A + (size_t)nxt.pm * tstep : cA; const char* nB = has_next ? (const char*)g.Bt + (size_t)nxt.pn * tstep + (size_t)nxt.e * g.bstride : cB;
#pragma nounroll
        for (int t = 0; t < nt; t += 2) {
            const bool last = (t == nt - 2);
            const char* a1 = cA + (size_t)(t + 1) * kstep;
            const char* a2 = last ? nA : cA + (size_t)(t + 2) * kstep; const char* b2 = last ? nB : cB + (size_t)(t + 2) * kstep;
            const char* a3 = a2 + kstep; const char* b3 = b2 + kstep;
            if (last && has_next) S.a_ready(nxt);
            if constexpr (SP2) {
            PG8_LDB(B0, 0, 0); PG8_LDB(B1, 0, 1); PG8_SCHED; PG8_LDA(At, 0, 0); PG8_STAGE(PG8_SA(1, 1), a1 + hstep, voffA);
            PG8_WAIT_V(8); PG8_WAIT_L(0); PG8_BAR; PG8_MMA(0, 0, At, B0); PG8_MMA(0, 1, At, B1); PG8_BAR; PG8_SCHED;
            PG8_LDA(At, 0, 1); PG8_STAGE(PG8_SB(0, 0), b2, voffB); PG8_STAGE(PG8_SB(0, 1), b2 + hstep, voffB); PG8_STAGE(PG8_SA(0, 0), a2, voffA);
            PG8_WAIT_V(8); PG8_WAIT_L(0); PG8_BAR; PG8_MMA(1, 0, At, B0); PG8_MMA(1, 1, At, B1); PG8_BAR; PG8_SCHED;
            PG8_LDB(B0, 1, 0); PG8_LDB(B1, 1, 1); PG8_SCHED; PG8_LDA(At, 1, 0); PG8_STAGE(PG8_SA(0, 1), a2 + hstep, voffA);
            PG8_WAIT_V(8); PG8_WAIT_L(0); PG8_BAR; PG8_MMA(0, 0, At, B0); PG8_MMA(0, 1, At, B1); PG8_BAR; PG8_SCHED;
            PG8_LDA(At, 1, 1); PG8_STAGE(PG8_SB(1, 0), b3, voffB); PG8_STAGE(PG8_SB(1, 1), b3 + hstep, voffB); PG8_STAGE(PG8_SA(1, 0), a3, voffA);
            PG8_WAIT_V(8); PG8_WAIT_L(0); PG8_BAR; PG8_MMA(1, 0, At, B0); PG8_MMA(1, 1, At, B1); PG8_BAR; PG8_SCHED;
            } else {
            PG8_LDB(B0, 0, 0); PG8_SCHED; PG8_LDA(At, 0, 0); PG8_STAGE(PG8_SA(1, 1), a1 + hstep, voffA);
            PG8_WAIT_L(8); PG8_BAR; PG8_WAIT_L(0); PG8_MMA(0, 0, At, B0); PG8_BAR; PG8_SCHED;
            PG8_LDB(B1, 0, 1); PG8_STAGE(PG8_SB(0, 0), b2, voffB);
            PG8_BAR; PG8_WAIT_L(0); PG8_MMA(0, 1, At, B1); PG8_BAR;
            PG8_LDA(At, 0, 1); PG8_STAGE(PG8_SA(0, 0), a2, voffA);
            PG8_BAR; PG8_WAIT_L(0); PG8_MMA(1, 0, At, B0); PG8_BAR; PG8_SCHED;
            PG8_STAGE(PG8_SB(0, 1), b2 + hstep, voffB);
            PG8_WAIT_V(6); PG8_BAR; PG8_MMA(1, 1, At, B1); PG8_BAR;
            PG8_LDB(B0, 1, 0); PG8_SCHED; PG8_LDA(At, 1, 0); PG8_STAGE(PG8_SA(0, 1), a2 + hstep, voffA);
            PG8_WAIT_L(8); PG8_BAR; PG8_WAIT_L(0); PG8_MMA(0, 0, At, B0); PG8_BAR; PG8_SCHED;
            PG8_LDB(B1, 1, 1); PG8_STAGE(PG8_SB(1, 0), b3, voffB);
            PG8_BAR; PG8_WAIT_L(0); PG8_MMA(0, 1, At, B1); PG8_BAR;
            PG8_LDA(At, 1, 1); PG8_STAGE(PG8_SA(1, 0), a3, voffA);
            PG8_BAR; PG8_WAIT_L(0); PG8_MMA(1, 0, At, B0); PG8_BAR; PG8_SCHED;
            PG8_STAGE(PG8_SB(1, 1), b3 + hstep, voffB);
            PG8_WAIT_V(6); PG8_BAR; PG8_MMA(1, 1, At, B1); PG8_BAR;
            }
        }
        if constexpr (ALIGN_EPI) { if (wr == 0) PG8_BAR; }
        if constexpr (FP8) { asm volatile("s_nop 15\n\ts_nop 15\n\ts_nop 15\n\ts_nop 15" ::: "memory"); }
        if constexpr (!Epi::AFTER_DRAIN) { E(acc, cur, wr, wc, fr, fq); S.done(cur); }
        if (!has_next) break;
#pragma unroll
        for (int a = 0; a < 2; ++a)
#pragma unroll
            for (int b = 0; b < 2; ++b)
#pragma unroll
                for (int m = 0; m < 4; ++m)
#pragma unroll
                    for (int n = 0; n < 2; ++n) acc[a][b][m][n] = (f32x4){0.f, 0.f, 0.f, 0.f};
        cur = nxt; cA = nA; cB = nB; ++ui;
        if constexpr (ALIGN_EPI) { if (wr == 1) PG8_BAR; }
    }
    PG8_WAIT_V(0);
    if constexpr (!ALIGN_EPI) { if (wr == 0) PG8_BAR; }
    PG8_BAR;
    if constexpr (Epi::AFTER_DRAIN) { E.fused(acc, cur, wr, wc, fr, fq, lds, wid, lane); S.done(cur); }
#undef PG8_SA
#undef PG8_SB
#undef PG8_STAGE
#undef PG8_LDA
#undef PG8_LDB
#undef PG8_MMA
#undef PG8_WAIT_V
#undef PG8_WAIT_L
#undef PG8_BAR
#undef PG8_SCHED
}
}

#ifndef PG8_SP2
#define PG8_SP2 true
#endif

namespace pg8 {
DEV float fast_sigmoid(float x) { return __builtin_amdgcn_rcpf(1.f + __builtin_amdgcn_exp2f(-1.4426950409f * x)); }
DEV float fast_silu(float x) { return x * fast_sigmoid(x); }
DEV float fast_gelu_tanh(float x) { return x * __builtin_amdgcn_rcpf(1.f + __builtin_amdgcn_exp2f(-2.3022081984f * (x + 0.044715f * x * x * x))); }
DEV u32x4 pack8(const f32x4 a, const f32x4 b) { u32x4 w; w.x = cvt_pk_bf16(a[0], a[1]); w.y = cvt_pk_bf16(a[2], a[3]); w.z = cvt_pk_bf16(b[0], b[1]); w.w = cvt_pk_bf16(b[2], b[3]); return w; }

struct EpiIn0 {
    static constexpr bool PERM = true, AFTER_DRAIN = false;
    bf16_t* XA; bf16_t* GA; bf16_t* GLU;
    __device__ __forceinline__ void operator()(const f32x4 (&acc)[2][2][4][2], const Unit& u, int wr, int wc, int fr, int fq) const {
        const int row0 = u.pm * BM + wr * 64 + fr;
        if (u.pn < 4) {
            const bool isga = u.pn >= 2;
            if (isga && u.pm >= NTOK / BM) return;
            bf16_t* base = (isga ? GA : XA) + (u.pn & 1) * 256 + wc * 32 + 8 * fq;
#pragma unroll
            for (int ai = 0; ai < 2; ++ai)
#pragma unroll
                for (int m = 0; m < 4; ++m) { bf16_t* rowp = base + (size_t)(row0 + ai * HALF + m * 16) * AW;
#pragma unroll
                    for (int bj = 0; bj < 2; ++bj) { f32x4 v0 = acc[ai][bj][m][0], v1 = acc[ai][bj][m][1];
                        if (isga) {
#pragma unroll
                            for (int j = 0; j < 4; ++j) { v0[j] = fast_gelu_tanh(v0[j]); v1[j] = fast_gelu_tanh(v1[j]); } }
                        *(u32x4*)(rowp + bj * HALF) = pack8(v0, v1); } }
        } else {
            if (u.pm >= NTOK / BM) return;
            bf16_t* base = GLU + (u.pn - 4) * 128 + wc * 32 + 8 * fq;
#pragma unroll
            for (int ai = 0; ai < 2; ++ai)
#pragma unroll
                for (int m = 0; m < 4; ++m) { f32x4 v0, v1;
#pragma unroll
                    for (int j = 0; j < 4; ++j) { v0[j] = acc[ai][0][m][0][j] * fast_sigmoid(acc[ai][1][m][0][j]); v1[j] = acc[ai][0][m][1][j] * fast_sigmoid(acc[ai][1][m][1][j]); }
                    *(u32x4*)(base + (size_t)(row0 + ai * HALF + m * 16) * BWD) = pack8(v0, v1); }
        }
    }
};
struct EpiSwiglu {
    static constexpr bool PERM = true, AFTER_DRAIN = false;
    bf16_t* O; int ldc; int pad;
    __device__ __forceinline__ void operator()(const f32x4 (&acc)[2][2][4][2], const Unit& u, int wr, int wc, int fr, int fq) const {
        const int row0 = u.pm * BM + wr * 64 + fr;
        bf16_t* base = O + u.pn * 128 + wc * 32 + 8 * fq;
#pragma unroll
        for (int ai = 0; ai < 2; ++ai)
#pragma unroll
            for (int m = 0; m < 4; ++m) { f32x4 v0, v1;
#pragma unroll
                for (int j = 0; j < 4; ++j) { v0[j] = fast_silu(acc[ai][0][m][0][j]) * acc[ai][1][m][0][j]; v1[j] = fast_silu(acc[ai][0][m][1][j]) * acc[ai][1][m][1][j]; }
                *(u32x4*)(base + (size_t)(row0 + ai * HALF + m * 16) * ldc) = pack8(v0, v1); }
    }
};
DEV unsigned pk4_fp8(float a, float b, float c, float d) {
    a = __builtin_amdgcn_fmed3f(a, -440.f, 440.f); b = __builtin_amdgcn_fmed3f(b, -440.f, 440.f); c = __builtin_amdgcn_fmed3f(c, -440.f, 440.f); d = __builtin_amdgcn_fmed3f(d, -440.f, 440.f);
    int w = __builtin_amdgcn_cvt_pk_fp8_f32(a, b, 0, false); w = __builtin_amdgcn_cvt_pk_fp8_f32(c, d, w, true); return (unsigned)w; }
template <bool OUT8> struct EpiSwigluS {
    static constexpr bool PERM = true, AFTER_DRAIN = false;
    void* O; int ldc; float sa, so; int pad;
    __device__ __forceinline__ void operator()(const f32x4 (&acc)[2][2][4][2], const Unit& u, int wr_, int wc_, int fr_, int fq_) const {
        int t_ = threadIdx.x; asm volatile("" : "+v"(t_));
        const int wr = (t_ >> 8) & 1, wc = (t_ >> 6) & 3, fr = t_ & 15, fq = (t_ >> 4) & 3;
        const int row0 = u.pm * BM + wr * 64 + fr, col0 = u.pn * 128 + wc * 32 + 8 * fq;
#pragma unroll
        for (int ai = 0; ai < 2; ++ai)
#pragma unroll
            for (int m = 0; m < 4; ++m) { f32x4 v0, v1;
#pragma unroll
                for (int j = 0; j < 4; ++j) { v0[j] = fast_silu(acc[ai][0][m][0][j] * sa) * (acc[ai][1][m][0][j] * sa) * so; v1[j] = fast_silu(acc[ai][0][m][1][j] * sa) * (acc[ai][1][m][1][j] * sa) * so; }
                const size_t off = (size_t)(row0 + ai * HALF + m * 16) * ldc + col0;
                if constexpr (OUT8) { typedef unsigned u32x2 __attribute__((ext_vector_type(2))); u32x2 w; w.x = pk4_fp8(v0[0], v0[1], v0[2], v0[3]); w.y = pk4_fp8(v1[0], v1[1], v1[2], v1[3]); *(u32x2*)((unsigned char*)O + off) = w; }
                else *(u32x4*)((bf16_t*)O + off) = pack8(v0, v1); }
    }
};
struct EpiScaleBf16 {
    static constexpr bool PERM = true, AFTER_DRAIN = false;
    bf16_t* O; int ldc; float s;
    __device__ __forceinline__ void operator()(const f32x4 (&acc)[2][2][4][2], const Unit& u, int wr_, int wc_, int fr_, int fq_) const {
        int t_ = threadIdx.x; asm volatile("" : "+v"(t_));
        const int wr = (t_ >> 8) & 1, wc = (t_ >> 6) & 3, fr = t_ & 15, fq = (t_ >> 4) & 3;
        const int row0 = u.pm * BM + wr * 64 + fr, col0 = u.pn * BM + wc * 32 + 8 * fq;
#pragma unroll
        for (int ai = 0; ai < 2; ++ai)
#pragma unroll
            for (int m = 0; m < 4; ++m) { bf16_t* rowp = O + (size_t)(row0 + ai * HALF + m * 16) * ldc + col0;
#pragma unroll
                for (int bj = 0; bj < 2; ++bj) *(u32x4*)(rowp + bj * HALF) = pack8(acc[ai][bj][m][0] * s, acc[ai][bj][m][1] * s); }
    }
};
struct EpiIn1 {
    static constexpr bool PERM = true, AFTER_DRAIN = false;
    bf16_t* UVF; size_t stride;
    __device__ __forceinline__ void operator()(const f32x4 (&acc)[2][2][4][2], const Unit& u, int wr, int wc, int fr, int fq) const {
        const int row0 = u.pm * BM + wr * 64 + fr;
        const bool act = u.pn < 4;
        bf16_t* base = UVF + (size_t)(u.pn >> 1) * stride + (u.pn & 1) * 256 + wc * 32 + 8 * fq;
#pragma unroll
        for (int ai = 0; ai < 2; ++ai)
#pragma unroll
            for (int m = 0; m < 4; ++m) { bf16_t* rowp = base + (size_t)(row0 + ai * HALF + m * 16) * CWD;
#pragma unroll
                for (int bj = 0; bj < 2; ++bj) { f32x4 v0 = acc[ai][bj][m][0], v1 = acc[ai][bj][m][1];
                    if (act) {
#pragma unroll
                        for (int j = 0; j < 4; ++j) { v0[j] = fast_gelu_tanh(v0[j]); v1[j] = fast_gelu_tanh(v1[j]); } }
                    *(u32x4*)(rowp + bj * HALF) = pack8(v0, v1); } }
    }
};
struct EpiDft {
    static constexpr bool PERM = true, AFTER_DRAIN = false;
    bf16_t* A3;
    __device__ __forceinline__ void operator()(const f32x4 (&acc)[2][2][4][2], const Unit& u, int wr, int wc, int fr, int fq) const {
        const int row0 = u.pm * BM + wr * 64 + fr;
#pragma unroll
        for (int bj = 0; bj < 2; ++bj) { const int bg = u.pn * 2 + bj, b = bg >> 2, g = bg & 3;
            bf16_t* base = A3 + (size_t)b * SEQ * DM + CWD + g * DGD + wc * 32 + 8 * fq;
#pragma unroll
            for (int ai = 0; ai < 2; ++ai)
#pragma unroll
                for (int m = 0; m < 4; ++m) { const f32x4 v0 = acc[ai][bj][m][0] * (1.f / 512.f), v1 = acc[ai][bj][m][1] * (1.f / 512.f);
                    *(u32x4*)(base + (size_t)(row0 + ai * HALF + m * 16) * DM) = pack8(v0, v1); } }
    }
};
}

constexpr size_t MiB = 1u << 20;
constexpr size_t WS_CTL = 0, CTL_ZERO_BYTES = 1 * MiB;
constexpr size_t WS_ADA = 1 * MiB;
constexpr size_t WS_PE = WS_ADA + 512 * 1024;
constexpr size_t WS_ROUTE = 2 * MiB;
constexpr size_t WS_MW13 = 4 * MiB;
constexpr size_t WS_MW2 = 60 * MiB;
constexpr size_t WS_WIN0 = 116 * MiB, WS_WOUT0 = 120 * MiB, WS_W13 = 122 * MiB, WS_W2 = 133 * MiB, WS_CDIN = 139 * MiB, WS_CDOUT = 142 * MiB, WS_DFTA = 144 * MiB;
constexpr size_t WS_Y = 160 * MiB;
constexpr size_t WS_R2 = 192 * MiB;
constexpr size_t WS_XARAW = WS_R2, WS_GA = WS_R2 + 18 * MiB, WS_GLU = WS_R2 + 34 * MiB, WS_A2 = WS_R2 + 50 * MiB;
constexpr size_t WS_HL = WS_R2 + 82 * MiB, WS_PF = WS_R2 + 98 * MiB, WS_PB = WS_R2 + 114 * MiB, WS_AGG = WS_R2 + 130 * MiB;
constexpr size_t WS_ACT = WS_R2;
constexpr size_t WS_U = WS_R2, WS_V = WS_R2 + 16 * MiB, WS_F = WS_R2 + 32 * MiB, WS_ZT = WS_R2 + 82 * MiB;
constexpr size_t WS_H = 328 * MiB;
constexpr size_t WS_H8 = 364 * MiB;
constexpr size_t WS_HG = 380 * MiB;
constexpr size_t WS_YP = 414 * MiB;
constexpr size_t WS_ACTM = 116 * MiB;
constexpr size_t WS_END = 512 * MiB;
constexpr int CW_BAR = 4096;

constexpr int LDS_BYTES = 147456;
constexpr int RING_BYTES = 131072, LDSCTL_OFF = RING_BYTES, MISC_OFF = LDSCTL_OFF + 320;

#define GAS __attribute__((address_space(1)))
#define LAS __attribute__((address_space(3)))
typedef unsigned v4u __attribute__((ext_vector_type(4)));
typedef unsigned v2u __attribute__((ext_vector_type(2)));
typedef float f32x4 __attribute__((ext_vector_type(4)));
typedef short bf16x8 __attribute__((ext_vector_type(8)));
#define LDS_WAIT() asm volatile("s_waitcnt lgkmcnt(0)" ::: "memory")
#define VM_WAIT() asm volatile("s_waitcnt vmcnt(0)" ::: "memory")
DEV unsigned pk2(float lo, float hi) { return (unsigned)f2bf(lo) | ((unsigned)f2bf(hi) << 16); }

#define XB_TMO      128
#define XB_XCNT(j)  (256  + 64 * (j))
#define XB_XSUB(j)  (1280 + 64 * (j))
#define XB_XGEN(j)  (2304 + 64 * (j))
#define XB_TOP      3328
#define XB_TOPGEN   3392
#define XCD_BAR_WORDS 3456
#define XB_SPIN_CAP (1u << 18)
__device__ __forceinline__ unsigned xb_ld(unsigned* p)              { return __hip_atomic_load(p, __ATOMIC_RELAXED, __HIP_MEMORY_SCOPE_AGENT); }
__device__ __forceinline__ unsigned xb_add(unsigned* p, unsigned v) { return __hip_atomic_fetch_add(p, v, __ATOMIC_RELAXED, __HIP_MEMORY_SCOPE_AGENT); }
__device__ __forceinline__ unsigned xb_xcc_id() { return (unsigned)__builtin_amdgcn_s_getreg((3 << 11) | 20) & 0xFu; }
#define XB_SPIN(cond, bar) do { unsigned _sp = 0; while (cond) { __builtin_amdgcn_s_sleep(1); \
    if ((++_sp & 255u) == 0u) { if (xb_ld(&(bar)[XB_TMO])) break; if (_sp > XB_SPIN_CAP) { atomicAdd(&(bar)[XB_TMO], 1u); break; } } } } while (0)
struct XcdBarrier { unsigned* bar; unsigned x; volatile LAS unsigned* st; };
__device__ __forceinline__ XcdBarrier xcd_barrier_post(unsigned* bar, volatile LAS unsigned* st) {
    XcdBarrier b; b.bar = bar; b.x = xb_xcc_id(); b.st = st;
    if (threadIdx.x == 0) (void)xb_add(&bar[XB_XCNT(b.x)], 1u);
    return b;
}
__device__ __forceinline__ void xcd_barrier_complete(unsigned* bar, unsigned x, unsigned& nloc, unsigned& nx) {
    const unsigned G = gridDim.x * gridDim.y * gridDim.z;
    unsigned sum, cnt, mine, sp = 0u;
    for (;;) {
        sum = 0u; cnt = 0u; mine = 0u;
#pragma unroll
        for (unsigned j = 0; j < 16; ++j) { const unsigned c = xb_ld(&bar[XB_XCNT(j)]); sum += c; cnt += (c > 0u) ? 1u : 0u; mine = (j == x) ? c : mine; }
        if (sum == G) break;
        __builtin_amdgcn_s_sleep(1);
        if ((++sp & 255u) == 0u) { if (xb_ld(&bar[XB_TMO])) break; if (sp > XB_SPIN_CAP) { atomicAdd(&bar[XB_TMO], 1u); break; } }
    }
    nloc = mine > 0u ? mine : 1u; nx = cnt > 0u ? cnt : 1u;
}
__device__ __forceinline__ void xcd_barrier(const XcdBarrier& b) {
    asm volatile("s_waitcnt vmcnt(0)" ::: "memory");
    __syncthreads();
    if (threadIdx.x == 0) {
        unsigned* bar = b.bar;
        __builtin_amdgcn_s_waitcnt(0);
        unsigned nloc = b.st[0], nx = b.st[1];
        if (nloc == 0u) { xcd_barrier_complete(bar, b.x, nloc, nx); b.st[0] = nloc; b.st[1] = nx; }
        const unsigned old = xb_add(&bar[XB_XSUB(b.x)], 1u);
        const unsigned gen = old / nloc;
        if (old + 1u == (gen + 1u) * nloc) {
            __builtin_amdgcn_fence(__ATOMIC_RELEASE, "agent");
            asm volatile("s_waitcnt vmcnt(0)" ::: "memory");
            const unsigned og = xb_add(&bar[XB_TOP], 1u);
            const unsigned tg = og / nx;
            if (og + 1u == (tg + 1u) * nx) xb_add(&bar[XB_TOPGEN], 1u);
            else XB_SPIN(xb_ld(&bar[XB_TOPGEN]) == tg, bar);
            __builtin_amdgcn_fence(__ATOMIC_ACQUIRE, "agent");
            xb_add(&bar[XB_XGEN(b.x)], 1u);
            asm volatile("s_waitcnt vmcnt(0)" ::: "memory");
        } else {
            XB_SPIN(xb_ld(&bar[XB_XGEN(b.x)]) == gen, bar);
            __builtin_amdgcn_fence(__ATOMIC_ACQUIRE, "agent");
            asm volatile("s_waitcnt vmcnt(0)" ::: "memory");
        }
    }
    __syncthreads();
}

struct Args { const float* in[33]; float* out; unsigned char* ws; int ph_lo, ph_hi; };
struct Frame {
    LAS unsigned char* lds;
    volatile LAS unsigned* MISC;
    unsigned* ctl;
    int tid, lane, wave, vcu, G;
    const float* const* in;
    float* X; unsigned char* ws;
};
#define WSP(T, off) ((T*)(F.ws + (off)))

#ifndef MOE_G2_FP8
#define MOE_G2_FP8 1
#endif
constexpr float MOE_W13_SCALE = 32.f, MOE_W2_SCALE = 64.f, MOE_ACT_SCALE = 4.f;
struct WtJob { const float* W; bf16* WT; int ldw, col0, ncols, K, row_off, mode, half, f8; float scale; };
DEV void wt_item(const WtJob& j, int item, LAS float* scr, int lane) {
    const int nblk = j.ncols / 32, kb = item / nblk, nb = item % nblk, k0 = 64 * kb, n0 = 32 * nb;
    const float* W = j.W + (size_t)k0 * j.ldw + j.col0 + n0 + (lane & 31);
#pragma unroll 8
    for (int i = 0; i < 32; ++i) { const int kk = 2 * i + (lane >> 5); scr[kk * 33 + (lane & 31)] = W[(size_t)kk * j.ldw]; }
    LDS_WAIT(); asm volatile("" ::: "memory");
    const int c = lane & 7;
    const int nm0 = j.mode ? (n0 / 128) * 256 + j.half * 128 + (n0 % 128) : n0;
#pragma unroll
    for (int q = 0; q < 4; ++q) { const int n = (lane >> 3) + 8 * q; const LAS float* s = scr + (8 * c) * 33 + n;
        if (j.f8) { const float sc = j.scale; v2u o; o.x = pg8::pk4_fp8(s[0 * 33] * sc, s[1 * 33] * sc, s[2 * 33] * sc, s[3 * 33] * sc); o.y = pg8::pk4_fp8(s[4 * 33] * sc, s[5 * 33] * sc, s[6 * 33] * sc, s[7 * 33] * sc);
            *(GAS v2u*)((unsigned char*)j.WT + (size_t)(j.row_off + nm0 + n) * j.K + k0 + 8 * c) = o; }
        else { v4u o; o.x = pk2(s[0 * 33], s[1 * 33]); o.y = pk2(s[2 * 33], s[3 * 33]); o.z = pk2(s[4 * 33], s[5 * 33]); o.w = pk2(s[6 * 33], s[7 * 33]);
            *(GAS v4u*)(j.WT + (size_t)(j.row_off + nm0 + n) * j.K + k0 + 8 * c) = o; } }
    LDS_WAIT(); asm volatile("" ::: "memory");
}
constexpr int WT_BASE_ITEMS = 512 + 256 + 256 + 512 + 1408 * 3 + 768 + 512;
constexpr int WT_MOE_ITEMS = 1792;
constexpr int WT_ITEMS = WT_BASE_ITEMS + NE * 3 * WT_MOE_ITEMS;
#define WT_SET(W_, WT_, ldw_, col0_, ncols_, K_, row_off_, mode_, half_) do { j.W = (W_); j.WT = (WT_); j.ldw = (ldw_); j.col0 = (col0_); j.ncols = (ncols_); j.K = (K_); j.row_off = (row_off_); j.mode = (mode_); j.half = (half_); j.f8 = 0; j.scale = 1.f; } while (0)
DEV bool wt_job(const Frame& F, int it, WtJob& j, int& item) {
    int r = it;
    if (r < 512) { WT_SET(F.in[7], WSP(bf16, WS_WIN0), 2048, 0, 1024, DM, 0, 0, 0); item = r; return true; } r -= 512;
    if (r < 256) { WT_SET(F.in[7], WSP(bf16, WS_WIN0), 2048, 1024, 512, DM, 1024, 1, 0); item = r; return true; } r -= 256;
    if (r < 256) { WT_SET(F.in[7], WSP(bf16, WS_WIN0), 2048, 1536, 512, DM, 1024, 1, 1); item = r; return true; } r -= 256;
    if (r < 512) { WT_SET(F.in[19], WSP(bf16, WS_WOUT0), DM, 0, DM, DM, 0, 0, 0); item = r; return true; } r -= 512;
    if (r < 1408) { WT_SET(F.in[20], WSP(bf16, WS_W13), DFF, 0, DFF, DM, 0, 1, 0); item = r; return true; } r -= 1408;
    if (r < 1408) { WT_SET(F.in[21], WSP(bf16, WS_W13), DFF, 0, DFF, DM, 0, 1, 1); item = r; return true; } r -= 1408;
    if (r < 1408) { WT_SET(F.in[22], WSP(bf16, WS_W2), DM, 0, DM, DFF, 0, 0, 0); item = r; return true; } r -= 1408;
    if (r < 768) { WT_SET(F.in[23], WSP(bf16, WS_CDIN), 1536, 0, 1536, DM, 0, 0, 0); item = r; return true; } r -= 768;
    if (r < 512) { WT_SET(F.in[28], WSP(bf16, WS_CDOUT), DM, 0, DM, DM, 0, 0, 0); item = r; return true; } r -= 512;
    const int mi = r / WT_MOE_ITEMS, e = mi / 3, kind = mi % 3; item = r % WT_MOE_ITEMS;
    if (e >= NE) return false;
    if (kind == 0) { WT_SET(F.in[30] + (size_t)e * DM * DFE, (bf16*)(F.ws + WS_MW13 + (size_t)e * 2 * DFE * DM), DFE, 0, DFE, DM, 0, 1, 0); j.f8 = 1; j.scale = MOE_W13_SCALE; }
    else if (kind == 1) { WT_SET(F.in[31] + (size_t)e * DM * DFE, (bf16*)(F.ws + WS_MW13 + (size_t)e * 2 * DFE * DM), DFE, 0, DFE, DM, 0, 1, 1); j.f8 = 1; j.scale = MOE_W13_SCALE; }
    else { if (MOE_G2_FP8) { WT_SET(F.in[32] + (size_t)e * DFE * DM, (bf16*)(F.ws + WS_MW2 + (size_t)e * DM * DFE), DM, 0, DM, DFE, 0, 0, 0); j.f8 = 1; j.scale = MOE_W2_SCALE; }
           else WT_SET(F.in[32] + (size_t)e * DFE * DM, WSP(bf16, WS_MW2) + (size_t)e * DM * DFE, DM, 0, DM, DFE, 0, 0, 0); }
    return true;
}
DEV float wave_sum_all(float v) {
#pragma unroll
    for (int o = 1; o < 64; o <<= 1) v += __shfl_xor(v, o);
    return v;
}

DEV void p0_prologue(Frame& F) {
    const int tid = F.tid, lane = F.lane, wave = F.wave, bx = blockIdx.x;
    if (bx < 192) {
        LAS float* st = (LAS float*)(F.lds);
        LAS float* part = (LAS float*)(F.lds + 40960);
        const float* c = F.in[1]; const float* cctx = F.in[3];
        for (int i = tid; i < 9 * DM; i += 512) { const int r = i / DM, k = i % DM; const float v = r < 8 ? c[r * DM + k] : cctx[k]; st[i] = v / (1.f + expf(-v)); }
        __syncthreads();
        const int l = bx / 96, cs = (bx % 96) * 64;
        const float* w = F.in[4] + (size_t)l * DM * 6 * DM + cs + lane;
        float acc[9];
#pragma unroll
        for (int r = 0; r < 9; ++r) acc[r] = 0.f;
#pragma unroll 8
        for (int k = wave * 128; k < wave * 128 + 128; ++k) { const float wv = w[(size_t)k * 6 * DM];
#pragma unroll
            for (int r = 0; r < 9; ++r) acc[r] += st[r * DM + k] * wv; }
#pragma unroll
        for (int r = 0; r < 9; ++r) part[(wave * 9 + r) * 64 + lane] = acc[r];
        __syncthreads();
        float* ADA = WSP(float, WS_ADA);
        for (int i = tid; i < 9 * 64; i += 512) { const int r = i / 64, cl = i % 64; float s = F.in[5][l * 6 * DM + cs + cl];
#pragma unroll
            for (int w8 = 0; w8 < 8; ++w8) s += part[(w8 * 9 + r) * 64 + cl];
            ADA[(size_t)(l * 9 + r) * 6 * DM + cs + cl] = s; }
        __syncthreads();
    }
    { const int idx = bx * 512 + tid;
      if (idx < 96 * 512) { const int p = idx / 512, j = idx % 512, f = j % 256; const float pos = (float)(p < 32 ? p : p - 32);
          const float ang = pos * powf(10000.f, -(float)f / 256.f); WSP(float, WS_PE)[idx] = (j < 256) ? sinf(ang) : cosf(ang); } }
    { LAS float* T = (LAS float*)(F.lds);
      for (int i = tid; i < SEQ; i += 512) T[i] = cospif((float)i * (2.f / SEQ));
      __syncthreads();
      bf16* DFTA = WSP(bf16, WS_DFTA);
      for (int ch = tid; ch < 8 * 512; ch += 512) { const int k1 = 8 * bx + ch / 512, j0 = (ch % 512) * 8; const bool isc = j0 < SEQ; const int l0 = isc ? j0 : j0 - SEQ;
          float v[8];
#pragma unroll
          for (int q = 0; q < 8; ++q) { const int m = (k1 * (l0 + q)) & (SEQ - 1); v[q] = isc ? T[m] : -T[(m - SEQ / 4) & (SEQ - 1)]; }
          v4u o; o.x = pk2(v[0], v[1]); o.y = pk2(v[2], v[3]); o.z = pk2(v[4], v[5]); o.w = pk2(v[6], v[7]);
          *(GAS v4u*)(DFTA + (size_t)k1 * 2 * SEQ + j0) = o; }
      __syncthreads(); }
    { LAS float* scr = (LAS float*)(F.lds + wave * 16384);
      const int gw = F.vcu * 8 + wave, NGW = F.G * 8;
      for (int it = gw; it < WT_ITEMS; it += NGW) { WtJob j; int item; if (wt_job(F, it, j, item)) wt_item(j, item, scr, lane); } }
}

DEV void p1_rows(Frame& F) {
    const int lane = F.lane, gw = F.vcu * 8 + F.wave, NGW = F.G * 8;
    const float* ADA0 = WSP(float, WS_ADA); const float* PE = WSP(float, WS_PE); const float* gain = F.in[6];
    bf16* H = WSP(bf16, WS_H);
    for (int row = gw; row < NROWS; row += NGW) {
        const bool lat = row < NTOK;
        const f32x4* src = (const f32x4*)(lat ? F.in[0] + (size_t)row * DM : F.in[2] + (size_t)(row - NTOK) * DM);
        const int arow = lat ? row / SEQ : 8;
        f32x4 v[4];
#pragma unroll
        for (int j = 0; j < 4; ++j) v[j] = src[lane + 64 * j];
        if (lat) { const int t = row % SEQ; const f32x4* pr = (const f32x4*)(PE + (size_t)(t / GRIDW) * 512); const f32x4* pc = (const f32x4*)(PE + (size_t)(32 + t % GRIDW) * 512);
            v[0] += pr[lane]; v[1] += pr[lane + 64]; v[2] += pc[lane]; v[3] += pc[lane + 64];
            f32x4* xo = (f32x4*)(F.X + (size_t)row * DM);
#pragma unroll
            for (int j = 0; j < 4; ++j) xo[lane + 64 * j] = v[j]; }
        float ss = 0.f;
#pragma unroll
        for (int j = 0; j < 4; ++j) ss += (v[j][0] * v[j][0] + v[j][1] * v[j][1]) + (v[j][2] * v[j][2] + v[j][3] * v[j][3]);
        const float r = rsqrtf(wave_sum_all(ss) * (1.f / DM) + NORM_EPS);
        const f32x4* sh = (const f32x4*)(ADA0 + (size_t)arow * 6 * DM); const f32x4* sc = (const f32x4*)(ADA0 + (size_t)arow * 6 * DM + DM); const f32x4* g4 = (const f32x4*)gain;
        v2u* ho = (v2u*)(H + (size_t)row * DM);
#pragma unroll
        for (int j = 0; j < 4; ++j) { const f32x4 h = (v[j] * r * g4[lane + 64 * j]) * (1.f + sc[lane + 64 * j]) + sh[lane + 64 * j];
            v2u o; o.x = pk2(h[0], h[1]); o.y = pk2(h[2], h[3]); ho[lane + 64 * j] = o; }
    }
}
DEV void thin_rows(Frame& F, const bf16* Y, const float* gpost, const float* ADAres, int g_off, const float* gpre, const float* ADAnxt, int sh_off, int sc_off) {
    const int lane = F.lane, gw = F.vcu * 8 + F.wave, NGW = F.G * 8;
    bf16* H = WSP(bf16, WS_H);
    for (int row = gw; row < NTOK; row += NGW) {
        const int b = row / SEQ;
        const v2u* yp = (const v2u*)(Y + (size_t)row * DM);
        f32x4 y[4]; float ss = 0.f;
#pragma unroll
        for (int j = 0; j < 4; ++j) { const v2u w = yp[lane + 64 * j]; y[j][0] = __uint_as_float(w.x << 16); y[j][1] = __uint_as_float(w.x & 0xffff0000u); y[j][2] = __uint_as_float(w.y << 16); y[j][3] = __uint_as_float(w.y & 0xffff0000u);
            ss += (y[j][0] * y[j][0] + y[j][1] * y[j][1]) + (y[j][2] * y[j][2] + y[j][3] * y[j][3]); }
        const float ry = rsqrtf(wave_sum_all(ss) * (1.f / DM) + NORM_EPS);
        f32x4* xp = (f32x4*)(F.X + (size_t)row * DM);
        const f32x4* gt = (const f32x4*)(ADAres + (size_t)b * 6 * DM + g_off); const f32x4* gp = (const f32x4*)gpost;
        f32x4 x[4]; float sx = 0.f;
#pragma unroll
        for (int j = 0; j < 4; ++j) { x[j] = xp[lane + 64 * j] + gt[lane + 64 * j] * (y[j] * ry * gp[lane + 64 * j]); xp[lane + 64 * j] = x[j];
            sx += (x[j][0] * x[j][0] + x[j][1] * x[j][1]) + (x[j][2] * x[j][2] + x[j][3] * x[j][3]); }
        const float rx = rsqrtf(wave_sum_all(sx) * (1.f / DM) + NORM_EPS);
        const f32x4* sh = (const f32x4*)(ADAnxt + (size_t)b * 6 * DM + sh_off); const f32x4* sc = (const f32x4*)(ADAnxt + (size_t)b * 6 * DM + sc_off); const f32x4* g4 = (const f32x4*)gpre;
        v2u* ho = (v2u*)(H + (size_t)row * DM);
#pragma unroll
        for (int j = 0; j < 4; ++j) { const f32x4 h = (x[j] * rx * g4[lane + 64 * j]) * (1.f + sc[lane + 64 * j]) + sh[lane + 64 * j];
            v2u o; o.x = pk2(h[0], h[1]); o.y = pk2(h[2], h[3]); ho[lane + 64 * j] = o; }
    }
}


constexpr int P3_WB = 0, P3_CONST = 36864, P3_XAB = 40960, P3_XAF = 50176, P3_SUB = 66816, P3_OUTS = 83200;
constexpr int P3_ROWB = 144;
constexpr int P3_XAF_LD = 65;
constexpr int P3_OUT_LD = 72;
constexpr int P3B_IN = 0, P3B_OUT = 63488;
constexpr int NSLOT = 36;
DEV size_t agg_idx(int b, int slot, int dir, int k) { return ((size_t)(((b * NSLOT + slot) * 2 + dir) * 2 + k)) * AW; }
DEV void unpack8f(const v4u v, float* f) {
    f[0] = __uint_as_float(v.x << 16); f[1] = __uint_as_float(v.x & 0xffff0000u); f[2] = __uint_as_float(v.y << 16); f[3] = __uint_as_float(v.y & 0xffff0000u);
    f[4] = __uint_as_float(v.z << 16); f[5] = __uint_as_float(v.z & 0xffff0000u); f[6] = __uint_as_float(v.w << 16); f[7] = __uint_as_float(v.w & 0xffff0000u);
}
DEV float fsig(float x) { return __builtin_amdgcn_rcpf(1.f + __builtin_amdgcn_exp2f(-1.4426950409f * x)); }

DEV void mix0_local(Frame& F) {
    const int tid = F.tid, lane = F.lane, wave = F.wave, bx = blockIdx.x;
    {
        const float* dw_w = F.in[15]; const float* dw_b = F.in[16]; const float* ln_g = F.in[17]; const float* ln_b = F.in[18];
        const bf16* GLU = WSP(bf16, WS_GLU); bf16* A2 = WSP(bf16, WS_A2);
        const int cp = tid & 255, th = tid >> 8;
        float w0[CONVB], w1[CONVB];
#pragma unroll
        for (int j = 0; j < CONVB; ++j) { w0[j] = dw_w[j * BWD + 2 * cp]; w1[j] = dw_w[j * BWD + 2 * cp + 1]; }
        const float bias0 = dw_b[2 * cp], bias1 = dw_b[2 * cp + 1];
        for (int i = 0; i < 2; ++i) {
            const int tb = bx + 256 * i, b = tb >> 6, tseq0 = (tb & 63) * 32;
            for (int c = tid; c < 62 * 64; c += 512) { const int lr = c >> 6, cc = c & 63, ts = tseq0 - 15 + lr;
                v4u v = {0u, 0u, 0u, 0u};
                if (ts >= 0 && ts < SEQ) v = *(const GAS v4u*)(GLU + (size_t)(b * SEQ + ts) * BWD + cc * 8);
                *(LAS v4u*)(F.lds + P3B_IN + lr * 1024 + cc * 16) = v; }
            __syncthreads();
            float acc0[16], acc1[16];
#pragma unroll
            for (int t = 0; t < 16; ++t) { acc0[t] = bias0; acc1[t] = bias1; }
#pragma unroll
            for (int rr = 0; rr < 46; ++rr) {
                const unsigned w = *(const LAS unsigned*)(F.lds + P3B_IN + (16 * th + rr) * 1024 + cp * 4);
                const float x0 = __uint_as_float(w << 16), x1 = __uint_as_float(w & 0xffff0000u);
#pragma unroll
                for (int t = 0; t < 16; ++t) { const int j = rr - t; if (j >= 0 && j < CONVB) { acc0[t] += w0[j] * x0; acc1[t] += w1[j] * x1; } }
            }
#pragma unroll
            for (int t = 0; t < 16; ++t) { typedef float f32x2 __attribute__((ext_vector_type(2))); *(LAS f32x2*)(F.lds + P3B_OUT + ((16 * th + t) * 512 + 2 * cp) * 4) = (f32x2){acc0[t], acc1[t]}; }
            __syncthreads();
#pragma unroll
            for (int q = 0; q < 4; ++q) { const int tl = 4 * wave + q; const LAS f32x4* row = (const LAS f32x4*)(F.lds + P3B_OUT + tl * 2048);
                const f32x4 v0 = row[lane], v1 = row[lane + 64];
                const float mu = wave_sum_all((v0[0] + v0[1]) + (v0[2] + v0[3]) + (v1[0] + v1[1]) + (v1[2] + v1[3])) * (1.f / BWD);
                const f32x4 d0 = v0 - mu, d1 = v1 - mu;
                const float var = wave_sum_all((d0[0] * d0[0] + d0[1] * d0[1]) + (d0[2] * d0[2] + d0[3] * d0[3]) + (d1[0] * d1[0] + d1[1] * d1[1]) + (d1[2] * d1[2] + d1[3] * d1[3])) * (1.f / BWD);
                const float rs = rsqrtf(var + LN_EPS);
                const f32x4 g0 = ((const f32x4*)ln_g)[lane], g1 = ((const f32x4*)ln_g)[lane + 64], b0 = ((const f32x4*)ln_b)[lane], b1 = ((const f32x4*)ln_b)[lane + 64];
                f32x4 y0 = d0 * rs * g0 + b0, y1 = d1 * rs * g1 + b1;
#pragma unroll
                for (int k = 0; k < 4; ++k) { y0[k] = y0[k] * fsig(y0[k]); y1[k] = y1[k] * fsig(y1[k]); }
                bf16* orow = A2 + (size_t)(b * SEQ + tseq0 + tl) * DM + BWD;
                v2u o0, o1; o0.x = pk2(y0[0], y0[1]); o0.y = pk2(y0[2], y0[3]); o1.x = pk2(y1[0], y1[1]); o1.y = pk2(y1[2], y1[3]);
                ((v2u*)orow)[lane] = o0; ((v2u*)orow)[lane + 64] = o1; }
            __syncthreads();
        }
    }
    const int h = bx & 7;
    {
        for (int idx = tid; idx < 4 * 4096; idx += 512) { const int g = idx >> 12, d = (idx >> 6) & 63, e = idx & 63, dir = g >> 1;
            const float* src = ((g & 1) ? F.in[12] : F.in[10]) + (size_t)((dir * AHEADS + h) * AHD) * AHD;
            *(LAS bf16*)(F.lds + P3_WB + g * 9216 + e * P3_ROWB + d * 2) = f2bf(src[d * AHD + e]); }
        LAS float* cst = (LAS float*)(F.lds + P3_CONST);
        if (tid < 128) { const int dir = tid >> 6, e = tid & 63, ch = dir * AW + h * AHD + e;
            cst[(dir * 3 + 0) * 64 + e] = F.in[11][ch]; cst[(dir * 3 + 1) * 64 + e] = F.in[13][ch];
            const float nl = -F.in[14][ch]; cst[(dir * 3 + 2) * 64 + e] = nl > 20.f ? nl : log1pf(expf(nl)); }
        if (tid >= 128 && tid < 128 + 256) { const int q = tid - 128, j = q >> 6, e = q & 63; cst[384 + q] = F.in[8][j * AW + h * AHD + e]; }
        if (tid >= 384 && tid < 448) { const int e = tid - 384; cst[640 + e] = F.in[9][h * AHD + e]; }
        __syncthreads();
    }
    const bf16* XA_RAW = WSP(bf16, WS_XARAW);
    bf16* HLp = WSP(bf16, WS_HL); bf16* PFp = WSP(bf16, WS_PF); bf16* PBp = WSP(bf16, WS_PB); float* AGG = WSP(float, WS_AGG);
    const LAS float* cst = (const LAS float*)(F.lds + P3_CONST);
    LAS float* XAF = (LAS float*)(F.lds + P3_XAF);
    LAS float* SUB = (LAS float*)(F.lds + P3_SUB);
    const int mt = wave >> 1, nt0 = (wave & 1) * 2, fr = lane & 15, fq = lane >> 4, sidx = mt * 4 + fq;
    for (int i = 0; i < 9; ++i) {
        const int u = bx + 256 * i, cidx = u >> 3;
        const bool isctx = cidx >= 256;
        int b, cc, seg0, seglen, slot;
        if (!isctx) { b = cidx >> 5; cc = cidx & 31; seg0 = b * SEQ; seglen = SEQ; slot = 4 + cc; }
        else { const int k = cidx - 256; b = k >> 2; cc = k & 3; seg0 = NTOK + b * CTXL; seglen = CTXL; slot = cc; }
        const int t0 = cc * 64;
        { const int t = tid >> 3, c8 = tid & 7;
          float acc[8];
#pragma unroll
          for (int q = 0; q < 8; ++q) acc[q] = cst[640 + c8 * 8 + q];
#pragma unroll
          for (int j = 0; j < 4; ++j) { const int tt = t0 + t + j - 1;
              if (tt >= 0 && tt < seglen) { float xv[8]; unpack8f(*(const GAS v4u*)(XA_RAW + (size_t)(seg0 + tt) * AW + h * AHD + c8 * 8), xv);
#pragma unroll
                  for (int q = 0; q < 8; ++q) acc[q] += cst[384 + j * 64 + c8 * 8 + q] * xv[q]; } }
#pragma unroll
          for (int q = 0; q < 8; ++q) XAF[t * P3_XAF_LD + c8 * 8 + q] = acc[q];
          v4u o; o.x = pk2(acc[0], acc[1]); o.y = pk2(acc[2], acc[3]); o.z = pk2(acc[4], acc[5]); o.w = pk2(acc[6], acc[7]);
          *(LAS v4u*)(F.lds + P3_XAB + t * P3_ROWB + c8 * 16) = o; }
        __syncthreads();
        float hlf[2][4], pf[2][4], hlb[2][4], pb[2][4];
        { bf16x8 afr[2];
#pragma unroll
          for (int ks = 0; ks < 2; ++ks) afr[ks] = *(const LAS bf16x8*)(F.lds + P3_XAB + (mt * 16 + fr) * P3_ROWB + (ks * 32 + fq * 8) * 2);
#pragma unroll
          for (int ntl = 0; ntl < 2; ++ntl) { const int nt = nt0 + ntl, ch = nt * 16 + fr;
              f32x4 acc[4];
#pragma unroll
              for (int g = 0; g < 4; ++g) { acc[g] = (f32x4){0.f, 0.f, 0.f, 0.f};
#pragma unroll
                  for (int ks = 0; ks < 2; ++ks) { const bf16x8 bfr = *(const LAS bf16x8*)(F.lds + P3_WB + g * 9216 + (nt * 16 + fr) * P3_ROWB + (ks * 32 + fq * 8) * 2);
                      acc[g] = __builtin_amdgcn_mfma_f32_16x16x32_bf16(afr[ks], bfr, acc[g], 0, 0, 0); } }
              float xa[4];
#pragma unroll
              for (int q = 0; q < 4; ++q) xa[q] = XAF[(mt * 16 + 4 * fq + q) * P3_XAF_LD + ch];
#pragma unroll
              for (int dir = 0; dir < 2; ++dir) { const float br = cst[(dir * 3 + 0) * 64 + ch], bi = cst[(dir * 3 + 1) * 64 + ch], sp = cst[(dir * 3 + 2) * 64 + ch];
                  float av[4], bv[4];
#pragma unroll
                  for (int q = 0; q < 4; ++q) { const float r = fsig(acc[2 * dir][q] + br), ig = fsig(acc[2 * dir + 1][q] + bi);
                      const float la = -8.f * r * sp; const float a = __builtin_amdgcn_exp2f(1.4426950409f * la);
                      av[q] = a; bv[q] = sqrtf(fmaxf(1.f - a * a, 0.f)) * (ig * xa[q]); }
                  if (dir == 0) { float hh = 0.f, pp = 1.f;
#pragma unroll
                      for (int q = 0; q < 4; ++q) { hh = av[q] * hh + bv[q]; pp *= av[q]; hlf[ntl][q] = hh; pf[ntl][q] = pp; }
                      typedef float f32x2 __attribute__((ext_vector_type(2))); *(LAS f32x2*)(SUB + ((0 * 16 + sidx) * 64 + ch) * 2) = (f32x2){pp, hh}; }
                  else { float hh = 0.f, pp = 1.f;
#pragma unroll
                      for (int q = 3; q >= 0; --q) { hh = av[q] * hh + bv[q]; pp *= av[q]; hlb[ntl][q] = hh; pb[ntl][q] = pp; }
                      typedef float f32x2 __attribute__((ext_vector_type(2))); *(LAS f32x2*)(SUB + ((1 * 16 + sidx) * 64 + ch) * 2) = (f32x2){pp, hh}; } } } }
        __syncthreads();
#pragma unroll
        for (int ntl = 0; ntl < 2; ++ntl) { const int ch = (nt0 + ntl) * 16 + fr;
            typedef float f32x2 __attribute__((ext_vector_type(2)));
            float cf = 0.f, apf = 1.f;
            for (int s = 0; s < sidx; ++s) { const f32x2 ab = *(const LAS f32x2*)(SUB + ((0 * 16 + s) * 64 + ch) * 2); cf = ab.x * cf + ab.y; apf *= ab.x; }
            float cb = 0.f, apb = 1.f;
            for (int s = 15; s > sidx; --s) { const f32x2 ab = *(const LAS f32x2*)(SUB + ((1 * 16 + s) * 64 + ch) * 2); cb = ab.x * cb + ab.y; apb *= ab.x; }
            if (sidx == 15) { const f32x2 ab = *(const LAS f32x2*)(SUB + ((0 * 16 + 15) * 64 + ch) * 2);
                AGG[agg_idx(b, slot, 0, 0) + h * AHD + ch] = apf * ab.x; AGG[agg_idx(b, slot, 0, 1) + h * AHD + ch] = ab.x * cf + ab.y; }
            if (sidx == 0) { const f32x2 ab = *(const LAS f32x2*)(SUB + ((1 * 16 + 0) * 64 + ch) * 2);
                AGG[agg_idx(b, slot, 1, 0) + h * AHD + ch] = apb * ab.x; AGG[agg_idx(b, slot, 1, 1) + h * AHD + ch] = ab.x * cb + ab.y; }
            if (!isctx) {
#pragma unroll
                for (int q = 0; q < 4; ++q) { const int t = mt * 16 + 4 * fq + q;
                    const float hl = (hlf[ntl][q] + pf[ntl][q] * cf) + (hlb[ntl][q] + pb[ntl][q] * cb);
                    *(LAS bf16*)(F.lds + P3_OUTS + (0 * 64 + t) * (P3_OUT_LD * 2) + ch * 2) = f2bf(hl);
                    *(LAS bf16*)(F.lds + P3_OUTS + (1 * 64 + t) * (P3_OUT_LD * 2) + ch * 2) = f2bf(pf[ntl][q] * apf);
                    *(LAS bf16*)(F.lds + P3_OUTS + (2 * 64 + t) * (P3_OUT_LD * 2) + ch * 2) = f2bf(pb[ntl][q] * apb); } } }
        __syncthreads();
        if (!isctx) { const int t = tid >> 3, c8 = tid & 7; const size_t go = (size_t)(seg0 + t0 + t) * AW + h * AHD + c8 * 8;
            *(GAS v4u*)(HLp + go) = *(const LAS v4u*)(F.lds + P3_OUTS + (0 * 64 + t) * (P3_OUT_LD * 2) + c8 * 16);
            *(GAS v4u*)(PFp + go) = *(const LAS v4u*)(F.lds + P3_OUTS + (1 * 64 + t) * (P3_OUT_LD * 2) + c8 * 16);
            *(GAS v4u*)(PBp + go) = *(const LAS v4u*)(F.lds + P3_OUTS + (2 * 64 + t) * (P3_OUT_LD * 2) + c8 * 16); }
    }
    __syncthreads();
}

DEV void mix0_carry(Frame& F) {
    const int tid = F.tid, wave = F.wave, lane = F.lane;
    const float* AGG = WSP(float, WS_AGG);
    const bf16* HLp = WSP(bf16, WS_HL); const bf16* PFp = WSP(bf16, WS_PF); const bf16* PBp = WSP(bf16, WS_PB); const bf16* GA = WSP(bf16, WS_GA); bf16* A2 = WSP(bf16, WS_A2);
    LAS float* CF = (LAS float*)(F.lds); LAS float* CB = CF + AW;
    for (int u = blockIdx.x; u < NB * 32; u += F.G) {
        const int b = u >> 5, lc = u & 31, ch = tid;
        { float c = 0.f;
          for (int s = 0; s < 4 + lc; ++s) c = AGG[agg_idx(b, s, 0, 0) + ch] * c + AGG[agg_idx(b, s, 0, 1) + ch];
          CF[ch] = c;
          c = 0.f;
          for (int s = 3; s >= 0; --s) c = AGG[agg_idx(b, s, 1, 0) + ch] * c + AGG[agg_idx(b, s, 1, 1) + ch];
          for (int s = NSLOT - 1; s > 4 + lc; --s) c = AGG[agg_idx(b, s, 1, 0) + ch] * c + AGG[agg_idx(b, s, 1, 1) + ch];
          CB[ch] = c; }
        __syncthreads();
        { const int c8 = lane; float cf[8], cb[8];
#pragma unroll
          for (int q = 0; q < 8; ++q) { cf[q] = CF[c8 * 8 + q]; cb[q] = CB[c8 * 8 + q]; }
#pragma unroll 2
          for (int q8 = 0; q8 < 8; ++q8) { const int row = b * SEQ + lc * 64 + wave * 8 + q8; const size_t go = (size_t)row * AW + c8 * 8;
              float hl[8], p1[8], p2[8], ga[8];
              unpack8f(*(const GAS v4u*)(HLp + go), hl); unpack8f(*(const GAS v4u*)(PFp + go), p1); unpack8f(*(const GAS v4u*)(PBp + go), p2); unpack8f(*(const GAS v4u*)(GA + go), ga);
              float r[8];
#pragma unroll
              for (int q = 0; q < 8; ++q) r[q] = (hl[q] + p1[q] * cf[q] + p2[q] * cb[q]) * ga[q];
              v4u o; o.x = pk2(r[0], r[1]); o.y = pk2(r[2], r[3]); o.z = pk2(r[4], r[5]); o.w = pk2(r[6], r[7]);
              *(GAS v4u*)(A2 + (size_t)row * DM + c8 * 8) = o; } }
        __syncthreads();
    }
}


constexpr int P11_WS = 0, P11_VT = 34816, P11_OUT = 52224, P11_BS = 70656;
constexpr int P11_CS = 0, P11_OUT2 = 69632;
constexpr int P11_PITCH = 272;

DEV void mix1_phase(Frame& F) {
    const int tid = F.tid, lane = F.lane, wave = F.wave, bx = blockIdx.x, fr = lane & 15, fq = lane >> 4;
    const int h = bx & 7;
    {
        const float* ws = F.in[26] + (size_t)h * CHUNK * CHUNK;
        for (int idx = tid; idx < CHUNK * CHUNK / 2; idx += 512) { const int p = idx >> 6, q2 = idx & 63;
            *(LAS unsigned*)(F.lds + P11_WS + p * P11_PITCH + q2 * 4) = pk2(ws[p * CHUNK + 2 * q2], ws[p * CHUNK + 2 * q2 + 1]); }
        if (tid < CHUNK) ((LAS float*)(F.lds + P11_BS))[tid] = F.in[27][h * CHUNK + tid];
        __syncthreads();
    }
    const bf16* U = WSP(bf16, WS_U); const bf16* V = WSP(bf16, WS_V); bf16* A3 = WSP(bf16, WS_A2);
    const float* ln_g = F.in[24]; const float* ln_b = F.in[25];
    for (int i = 0; i < 4; ++i) {
        const int u = bx + 256 * i, bn = u >> 3, r0 = bn * CHUNK;
        { float gg[8], bb[8];
#pragma unroll
          for (int j = 0; j < 8; ++j) { gg[j] = ln_g[8 * lane + j]; bb[j] = ln_b[8 * lane + j]; }
          for (int tk = 0; tk < 16; ++tk) { const int q = 16 * wave + tk;
              float v[8]; unpack8f(*(const GAS v4u*)(V + (size_t)(r0 + q) * CWD + 8 * lane), v);
              float s = 0.f;
#pragma unroll
              for (int j = 0; j < 8; ++j) s += v[j];
              const float mu = wave_sum_all(s) * (1.f / CWD);
              float s2 = 0.f;
#pragma unroll
              for (int j = 0; j < 8; ++j) { v[j] -= mu; s2 += v[j] * v[j]; }
              const float rs = rsqrtf(wave_sum_all(s2) * (1.f / CWD) + LN_EPS);
              if ((lane >> 3) == h) { const int d0 = 8 * (lane & 7);
#pragma unroll
                  for (int j = 0; j < 8; ++j) *(LAS bf16*)(F.lds + P11_VT + (d0 + j) * P11_PITCH + q * 2) = f2bf(v[j] * rs * gg[j] + bb[j]); } } }
        __syncthreads();
        { bf16x8 bfr[4];
#pragma unroll
          for (int ks = 0; ks < 4; ++ks) bfr[ks] = *(const LAS bf16x8*)(F.lds + P11_WS + (16 * wave + fr) * P11_PITCH + (ks * 32 + fq * 8) * 2);
          const int p = 16 * wave + fr; const float bias = ((const LAS float*)(F.lds + P11_BS))[p];
#pragma unroll
          for (int mt = 0; mt < 4; ++mt) { f32x4 acc = {0.f, 0.f, 0.f, 0.f};
#pragma unroll
              for (int ks = 0; ks < 4; ++ks) { const bf16x8 afr = *(const LAS bf16x8*)(F.lds + P11_VT + (16 * mt + fr) * P11_PITCH + (ks * 32 + fq * 8) * 2);
                  acc = __builtin_amdgcn_mfma_f32_16x16x32_bf16(afr, bfr[ks], acc, 0, 0, 0); }
              const int d = 16 * mt + 4 * fq;
              const v2u uw = *(const GAS v2u*)(U + (size_t)(r0 + p) * CWD + h * CHD + d);
              const float u0 = __uint_as_float(uw.x << 16), u1 = __uint_as_float(uw.x & 0xffff0000u), u2 = __uint_as_float(uw.y << 16), u3 = __uint_as_float(uw.y & 0xffff0000u);
              v2u o; o.x = pk2((acc[0] + bias) * u0, (acc[1] + bias) * u1); o.y = pk2((acc[2] + bias) * u2, (acc[3] + bias) * u3);
              *(LAS v2u*)(F.lds + P11_OUT + p * 144 + d * 2) = o; } }
        __syncthreads();
#pragma unroll
        for (int k = 0; k < 2; ++k) { const int c = tid + 512 * k, p = c >> 3, c8 = c & 7;
            *(GAS v4u*)(A3 + (size_t)(r0 + p) * DM + h * CHD + c8 * 8) = *(const LAS v4u*)(F.lds + P11_OUT + p * 144 + c8 * 16); }
    }
    __syncthreads();
    for (int idx = tid; idx < 256 * DGD; idx += 512) { const int k2p = idx >> 7, d = idx & 127, m = ((k2p & 127) * d) & 127; const float ang = (float)m * (1.f / 64.f);
        *(LAS bf16*)(F.lds + P11_CS + k2p * P11_PITCH + d * 2) = f2bf(k2p < 128 ? cospif(ang) : sinpif(ang)); }
    __syncthreads();
    const bf16* Fb = WSP(bf16, WS_F); bf16* ZT = WSP(bf16, WS_ZT);
    for (int i = 0; i < 4; ++i) {
        const int u = bx + 256 * i, b = u >> 7, g = (u >> 5) & 3, l0 = (u & 31) * 64;
        const int mt = wave & 3, nh = wave >> 2;
        bf16x8 afr[4];
#pragma unroll
        for (int ks = 0; ks < 4; ++ks) afr[ks] = *(const GAS bf16x8*)(Fb + (size_t)(b * SEQ + l0 + 16 * mt + fr) * DWD + g * DGD + ks * 32 + fq * 8);
#pragma unroll
        for (int ntl = 0; ntl < 8; ++ntl) { const int nt = nh * 8 + ntl; f32x4 acc = {0.f, 0.f, 0.f, 0.f};
#pragma unroll
            for (int ks = 0; ks < 4; ++ks) { const bf16x8 bfr = *(const LAS bf16x8*)(F.lds + P11_CS + (16 * nt + fr) * P11_PITCH + (ks * 32 + fq * 8) * 2);
                acc = __builtin_amdgcn_mfma_f32_16x16x32_bf16(afr[ks], bfr, acc, 0, 0, 0); }
            v2u o; o.x = pk2(acc[0], acc[1]); o.y = pk2(acc[2], acc[3]);
            *(LAS v2u*)(F.lds + P11_OUT2 + (16 * nt + fr) * 144 + (16 * mt + 4 * fq) * 2) = o; }
        __syncthreads();
#pragma unroll
        for (int k = 0; k < 4; ++k) { const int c = tid + 512 * k, k2p = c >> 3, c8 = c & 7, half = k2p >> 7, k2 = k2p & 127;
            *(GAS v4u*)(ZT + (size_t)((b * DGROUPS + g) * DGD + k2) * (2 * SEQ) + half * SEQ + l0 + c8 * 8) = *(const LAS v4u*)(F.lds + P11_OUT2 + k2p * 144 + c8 * 16); }
        __syncthreads();
    }
}

constexpr size_t RT_HIST = 0, RT_TT = 16 * 1024, RT_RE = 64 * 1024, RT_RP = 128 * 1024, RT_SLOT = 256 * 1024;
constexpr int MOE_ROWS = 34816;

DEV void moe_route(Frame& F) {
    const int lane = F.lane, wave = F.wave, tid = F.tid;
    const float* ADA1 = WSP(float, WS_ADA) + 9 * 6 * DM; const float* ng1 = F.in[6] + 4 * DM; const float* router = F.in[29];
    const bf16* Y = WSP(bf16, WS_Y); unsigned char* H8 = F.ws + WS_H8;
    int* RE = (int*)(F.ws + WS_ROUTE + RT_RE); float* RP = (float*)(F.ws + WS_ROUTE + RT_RP); int* HIST = (int*)(F.ws + WS_ROUTE + RT_HIST);
    LAS int* hist = (LAS int*)(F.lds);
    if (tid < NE) hist[tid] = 0;
    __syncthreads();
    for (int vb = F.vcu; vb < NTOK / 64; vb += F.G) {
        for (int k = 0; k < 8; ++k) {
            const int row = vb * 64 + wave * 8 + k, b = row / SEQ;
            const v2u* yp = (const v2u*)(Y + (size_t)row * DM);
            f32x4 y[4]; float ss = 0.f;
#pragma unroll
            for (int j = 0; j < 4; ++j) { const v2u w = yp[lane + 64 * j]; y[j][0] = __uint_as_float(w.x << 16); y[j][1] = __uint_as_float(w.x & 0xffff0000u); y[j][2] = __uint_as_float(w.y << 16); y[j][3] = __uint_as_float(w.y & 0xffff0000u);
                ss += (y[j][0] * y[j][0] + y[j][1] * y[j][1]) + (y[j][2] * y[j][2] + y[j][3] * y[j][3]); }
            const float ry = rsqrtf(wave_sum_all(ss) * (1.f / DM) + NORM_EPS);
            f32x4* xp = (f32x4*)(F.X + (size_t)row * DM);
            const f32x4* gt = (const f32x4*)(ADA1 + (size_t)b * 6 * DM + 2 * DM); const f32x4* gp = (const f32x4*)(ng1 + 1 * DM);
            f32x4 x[4]; float sx = 0.f;
#pragma unroll
            for (int j = 0; j < 4; ++j) { x[j] = xp[lane + 64 * j] + gt[lane + 64 * j] * (y[j] * ry * gp[lane + 64 * j]); xp[lane + 64 * j] = x[j];
                sx += (x[j][0] * x[j][0] + x[j][1] * x[j][1]) + (x[j][2] * x[j][2] + x[j][3] * x[j][3]); }
            const float rx = rsqrtf(wave_sum_all(sx) * (1.f / DM) + NORM_EPS);
            const f32x4* sh = (const f32x4*)(ADA1 + (size_t)b * 6 * DM + 3 * DM); const f32x4* sc = (const f32x4*)(ADA1 + (size_t)b * 6 * DM + 4 * DM); const f32x4* g4 = (const f32x4*)(ng1 + 2 * DM);
            unsigned* ho = (unsigned*)(H8 + (size_t)row * DM);
            float lg[NE];
#pragma unroll
            for (int e = 0; e < NE; ++e) lg[e] = 0.f;
#pragma unroll
            for (int j = 0; j < 4; ++j) { const f32x4 hv = (x[j] * rx * g4[lane + 64 * j]) * (1.f + sc[lane + 64 * j]) + sh[lane + 64 * j];
                ho[lane + 64 * j] = pg8::pk4_fp8(hv[0], hv[1], hv[2], hv[3]);
#pragma unroll
                for (int q = 0; q < 4; ++q) { const f32x4* rr = (const f32x4*)(router + (size_t)(4 * (lane + 64 * j) + q) * NE); const f32x4 r0 = rr[0], r1 = rr[1];
                    lg[0] += hv[q] * r0[0]; lg[1] += hv[q] * r0[1]; lg[2] += hv[q] * r0[2]; lg[3] += hv[q] * r0[3];
                    lg[4] += hv[q] * r1[0]; lg[5] += hv[q] * r1[1]; lg[6] += hv[q] * r1[2]; lg[7] += hv[q] * r1[3]; } }
#pragma unroll
            for (int e = 0; e < NE; ++e) lg[e] = wave_sum_all(lg[e]);
            int i1 = 0; float v1 = lg[0];
#pragma unroll
            for (int e = 1; e < NE; ++e) if (lg[e] > v1) { v1 = lg[e]; i1 = e; }
            int i2 = -1; float v2 = -3.0e38f;
#pragma unroll
            for (int e = 0; e < NE; ++e) if (e != i1 && lg[e] > v2) { v2 = lg[e]; i2 = e; }
            const float p2 = 1.f / (1.f + expf(v1 - v2)), p1 = 1.f - p2;
            if (lane == 0) { RE[row] = i1 | (i2 << 8); RP[2 * row] = p1; RP[2 * row + 1] = p2; atomicAdd((int*)&hist[i1], 1); atomicAdd((int*)&hist[i2], 1); }
        }
        __syncthreads();
        if (tid < NE) { HIST[vb * NE + tid] = hist[tid]; hist[tid] = 0; }
        __syncthreads();
    }
}
DEV void moe_gather(Frame& F) {
    const int tid = F.tid;
    const int* HIST = (const int*)(F.ws + WS_ROUTE + RT_HIST); const int* RE = (const int*)(F.ws + WS_ROUTE + RT_RE);
    int* TT = (int*)(F.ws + WS_ROUTE + RT_TT); int* SLOT = (int*)(F.ws + WS_ROUTE + RT_SLOT);
    const unsigned char* H8 = F.ws + WS_H8; unsigned char* HG = F.ws + WS_HG;
    LAS int* tot = (LAS int*)(F.lds);
    LAS int* before = tot + 8;
    LAS int* ent = tot + 16;
    LAS int* slot = tot + 16 + 128;
    for (int vb = F.vcu; vb < NTOK / 64; vb += F.G) {
        if (tid < NE) { int t = 0, bf = 0; for (int k = 0; k < NTOK / 64; ++k) { const int c = HIST[k * NE + tid]; t += c; bf += (k < vb) ? c : 0; } tot[tid] = t; before[tid] = bf; }
        if (tid >= 64 && tid < 128) { const int t = tid - 64; const int re = RE[vb * 64 + t]; ent[2 * t] = re & 0xff; ent[2 * t + 1] = (re >> 8) & 0xff; }
        __syncthreads();
        if (tid < 128) { const int e = ent[tid]; int rank = 0; for (int k = 0; k < tid; ++k) rank += (ent[k] == e) ? 1 : 0;
            int base = 0; for (int k = 0; k < e; ++k) base += ((tot[k] + 255) >> 8) << 8;
            const int s = base + before[e] + rank; slot[tid] = s; SLOT[(vb * 64) * 2 + tid] = s; }
        if (vb == 0 && tid == 128) { int nt = 0; for (int e = 0; e < NE; ++e) { const int n = (tot[e] + 255) >> 8; for (int k = 0; k < n; ++k) TT[1 + nt + k] = e; nt += n; } TT[0] = nt; }
        __syncthreads();
        for (int c = tid; c < 128 * 64; c += 512) { const int en = c >> 6, ck = c & 63;
            *(GAS v4u*)(HG + (size_t)slot[en] * DM + ck * 16) = *(const GAS v4u*)(H8 + (size_t)(vb * 64 + (en >> 1)) * DM + ck * 16); }
        __syncthreads();
    }
}
namespace pg8 {
struct MoeOrder : StaticOrder {
    const int* tt;
    __device__ __forceinline__ bool next(int i, Unit& u) const { if (!StaticOrder::next(i, u)) return false; u.e = tt[1 + u.pm]; return true; }
};
}
DEV void moe_final(Frame& F) {
    const int lane = F.lane, gw = F.vcu * 8 + F.wave, NGW = F.G * 8;
    const float* ADA1 = WSP(float, WS_ADA) + 9 * 6 * DM; const float* ng1 = F.in[6] + 4 * DM;
    const bf16* YP = WSP(bf16, WS_YP); const int* SLOT = (const int*)(F.ws + WS_ROUTE + RT_SLOT); const float* RP = (const float*)(F.ws + WS_ROUTE + RT_RP);
    for (int row = gw; row < NTOK; row += NGW) {
        const int b = row / SEQ, s1 = SLOT[2 * row], s2 = SLOT[2 * row + 1]; const float p1 = RP[2 * row], p2 = RP[2 * row + 1];
        const v2u* y1 = (const v2u*)(YP + (size_t)s1 * DM); const v2u* y2 = (const v2u*)(YP + (size_t)s2 * DM);
        f32x4 y[4]; float ss = 0.f;
#pragma unroll
        for (int j = 0; j < 4; ++j) { const v2u w = y1[lane + 64 * j], z = y2[lane + 64 * j];
            y[j][0] = p1 * __uint_as_float(w.x << 16) + p2 * __uint_as_float(z.x << 16); y[j][1] = p1 * __uint_as_float(w.x & 0xffff0000u) + p2 * __uint_as_float(z.x & 0xffff0000u);
            y[j][2] = p1 * __uint_as_float(w.y << 16) + p2 * __uint_as_float(z.y << 16); y[j][3] = p1 * __uint_as_float(w.y & 0xffff0000u) + p2 * __uint_as_float(z.y & 0xffff0000u);
            ss += (y[j][0] * y[j][0] + y[j][1] * y[j][1]) + (y[j][2] * y[j][2] + y[j][3] * y[j][3]); }
        const float ry = rsqrtf(wave_sum_all(ss) * (1.f / DM) + NORM_EPS);
        f32x4* xp = (f32x4*)(F.X + (size_t)row * DM);
        const f32x4* gt = (const f32x4*)(ADA1 + (size_t)b * 6 * DM + 5 * DM); const f32x4* gp = (const f32x4*)(ng1 + 3 * DM);
#pragma unroll
        for (int j = 0; j < 4; ++j) xp[lane + 64 * j] = xp[lane + 64 * j] + gt[lane + 64 * j] * (y[j] * ry * gp[lane + 64 * j]);
    }
}

constexpr int NPHASE = 19;
__global__ void __launch_bounds__(512, 2) mega_fwd(Args args) {
    extern __shared__ __attribute__((aligned(16))) unsigned char lds[];
    Frame F;
    F.lds = (LAS unsigned char*)lds;
    F.MISC = (volatile LAS unsigned*)(F.lds + MISC_OFF);
    F.tid = threadIdx.x; F.lane = F.tid & 63; F.wave = __builtin_amdgcn_readfirstlane(F.tid >> 6);
    F.G = gridDim.x; { const int bx = blockIdx.x; F.vcu = (F.G % 8 == 0) ? (bx % 8) * (F.G / 8) + bx / 8 : bx; }
    F.in = args.in; F.X = args.out; F.ws = args.ws; F.ctl = (unsigned*)(args.ws + WS_CTL);
    for (int u = F.tid; u < (LDS_BYTES - LDSCTL_OFF) / 4; u += 512) ((LAS unsigned*)(F.lds + LDSCTL_OFF))[u] = 0u;
    __syncthreads();
    const int lo = args.ph_lo, hi = args.ph_hi;
    XcdBarrier bar; bar.bar = F.ctl + CW_BAR; bar.x = 0; bar.st = nullptr;
    if (hi - lo > 1) bar = xcd_barrier_post(F.ctl + CW_BAR, F.MISC + 8);
#define IN(k) (lo <= (k) && (k) < hi)
#define SEAM(k) do { if (IN(k) && IN((k) + 1)) xcd_barrier(bar); } while (0)
    const float* ADA0 = WSP(float, WS_ADA); const float* ADA1 = ADA0 + 9 * 6 * DM;
    const float* ng0 = F.in[6]; const float* ng1 = F.in[6] + 4 * DM;

    if (IN(0)) { p0_prologue(F); } SEAM(0);
    if (IN(1)) { p1_rows(F); } SEAM(1);
    if (IN(2)) {
        pg8::Gemm g{WSP(bf16, WS_H), WSP(bf16, WS_WIN0), NROWS, 2048, DM, 0}; pg8::StaticOrder S; S.init(NROWS, 2048, F.G, (int)blockIdx.x);
        pg8::EpiIn0 E{WSP(bf16, WS_XARAW), WSP(bf16, WS_GA), WSP(bf16, WS_GLU)};
        pg8::gemm_phase<pg8::EpiIn0, pg8::StaticOrder, true, true>(F.lds, g, S, E);
    } SEAM(2);
    MIX0_PHASES
    if (IN(5)) {
        pg8::Gemm g{WSP(bf16, WS_A2), WSP(bf16, WS_WOUT0), NTOK, DM, DM, 0}; pg8::StaticOrder S; S.init(NTOK, DM, F.G, (int)blockIdx.x);
        pg8::EpiBf16<0> E{WSP(bf16, WS_Y), DM, nullptr, 0, 0, 1.f};
        pg8::gemm_phase<pg8::EpiBf16<0>, pg8::StaticOrder, true, true>(F.lds, g, S, E);
    } SEAM(5);
    if (IN(6)) { thin_rows(F, WSP(bf16, WS_Y), ng0 + 1 * DM, ADA0, 2 * DM, ng0 + 2 * DM, ADA0, 3 * DM, 4 * DM); } SEAM(6);
    if (IN(7)) {
        pg8::Gemm g{WSP(bf16, WS_H), WSP(bf16, WS_W13), NTOK, 2 * DFF, DM, 0}; pg8::StaticOrder S; S.init(NTOK, 2 * DFF, F.G, (int)blockIdx.x);
        pg8::EpiSwiglu E{WSP(bf16, WS_ACT), DFF, 0};
        pg8::gemm_phase<pg8::EpiSwiglu, pg8::StaticOrder, true, true>(F.lds, g, S, E);
    } SEAM(7);
    if (IN(8)) {
        pg8::Gemm g{WSP(bf16, WS_ACT), WSP(bf16, WS_W2), NTOK, DM, DFF, 0}; pg8::StaticOrder S; S.init(NTOK, DM, F.G, (int)blockIdx.x);
        pg8::EpiBf16<0> E{WSP(bf16, WS_Y), DM, nullptr, 0, 0, 1.f};
        pg8::gemm_phase<pg8::EpiBf16<0>, pg8::StaticOrder, true, true>(F.lds, g, S, E);
    } SEAM(8);
    if (IN(9)) { thin_rows(F, WSP(bf16, WS_Y), ng0 + 3 * DM, ADA0, 5 * DM, ng1 + 0 * DM, ADA1, 0 * DM, 1 * DM); } SEAM(9);
    if (IN(10)) {
        pg8::Gemm g{WSP(bf16, WS_H), WSP(bf16, WS_CDIN), NTOK, 1536, DM, 0}; pg8::StaticOrder S; S.init(NTOK, 1536, F.G, (int)blockIdx.x);
        pg8::EpiIn1 E{WSP(bf16, WS_U), (size_t)(WS_V - WS_U) / 2};
        pg8::gemm_phase<pg8::EpiIn1, pg8::StaticOrder, true, true>(F.lds, g, S, E);
    } SEAM(10);
    MIX1_PHASES
    if (IN(12)) {
        pg8::Gemm g{WSP(bf16, WS_DFTA), WSP(bf16, WS_ZT), SEQ, 4096, 2 * SEQ, 0}; pg8::StaticOrder S; S.init(SEQ, 4096, F.G, (int)blockIdx.x);
        pg8::EpiDft E{WSP(bf16, WS_A2)};
        pg8::gemm_phase<pg8::EpiDft, pg8::StaticOrder, true, true>(F.lds, g, S, E);
    } SEAM(12);
    if (IN(13)) {
        pg8::Gemm g{WSP(bf16, WS_A2), WSP(bf16, WS_CDOUT), NTOK, DM, DM, 0}; pg8::StaticOrder S; S.init(NTOK, DM, F.G, (int)blockIdx.x);
        pg8::EpiBf16<0> E{WSP(bf16, WS_Y), DM, nullptr, 0, 0, 1.f};
        pg8::gemm_phase<pg8::EpiBf16<0>, pg8::StaticOrder, true, true>(F.lds, g, S, E);
    } SEAM(13);
    MOE_PHASES
#undef IN
#undef SEAM
}

extern "C" void kernel_launch(void* const* d_in, const int* in_sizes, int n_in, void* d_out, int out_size, void* d_ws, size_t ws_size, hipStream_t stream) {
    static int grid = 0;
    if (grid == 0) {
        if (n_in != 33 || ws_size < WS_END || out_size != NTOK * DM) { fprintf(stderr, "kernel_launch: unexpected n_in %d / ws_size %zu / out_size %d\n", n_in, ws_size, out_size); grid = -1; return; }
        int dev = 0, cus = 0, per_cu = 0;
        if (hipGetDevice(&dev) != hipSuccess || hipDeviceGetAttribute(&cus, hipDeviceAttributeMultiprocessorCount, dev) != hipSuccess) { grid = -1; return; }
        if (hipFuncSetAttribute((const void*)mega_fwd, hipFuncAttributeMaxDynamicSharedMemorySize, LDS_BYTES) != hipSuccess) { fprintf(stderr, "kernel_launch: hipFuncSetAttribute failed\n"); grid = -1; return; }
        if (hipOccupancyMaxActiveBlocksPerMultiprocessor(&per_cu, (const void*)mega_fwd, 512, LDS_BYTES) != hipSuccess || per_cu < 1) { fprintf(stderr, "kernel_launch: occupancy query says %d\n", per_cu); }
        (void)hipGetLastError();
        grid = cus;
    }
    if (grid < 0) return;
    if (hipMemsetAsync((char*)d_ws + WS_CTL, 0, CTL_ZERO_BYTES, stream) != hipSuccess) return;
    Args a{};
    for (int i = 0; i < 33; ++i) a.in[i] = (const float*)d_in[i];
    a.out = (float*)d_out; a.ws = (unsigned char*)d_ws; a.ph_lo = 0; a.ph_hi = NPHASE;
    hipLaunchKernelGGL(mega_fwd, dim3(grid), dim3(512), LDS_BYTES, stream, a);
}
```
